# Optimizing an MI355X kernel written in HIP

```python
import math
import jax, jax.numpy as jnp
from jax import lax
import numpy as np

D_MODEL = 2048
BATCH = 8
SEQ = 4096
DEPTH = 2

CHUNK = 64
Q_BLOCK = 128
MIX_WIDTH = D_MODEL // 2
N_BRANCH = 3
H_A = MIX_WIDTH // 128
DH_A = 64
H_B = MIX_WIDTH // 128
DK_B = MIX_WIDTH // H_B
DV_B = MIX_WIDTH // H_B
H_C = 4
DK_C = MIX_WIDTH // (2 * H_C)
DV_C = MIX_WIDTH // H_C
GLA_GATE_RANK = 16
GLA_GATE_NORM = 16.0
D_FF = 11 * D_MODEL // 4
N_BUCKETS = 32
MAX_DISTANCE = 128
EPS = 1e-6

IN_SIZES = (
    H_A * 2 * DH_A, H_A * 2 * DH_A, H_A * 2 * DH_A,
    H_B * DK_B, H_B * DK_B, H_B * DV_B, H_B * DV_B,
    H_C * DK_C, H_C * DK_C, H_C * DV_C, H_C * DV_C, GLA_GATE_RANK,
    N_BRANCH * D_MODEL,
)
D_IN = sum(IN_SIZES)

kernel_name = 'chunk_causal_hybrid_diffattn_hgrn2_gla_macaron'


def rms_norm(x, gain):
    x32 = x.astype(jnp.float32)
    y = x32 * lax.rsqrt(jnp.mean(x32 * x32, axis=-1, keepdims=True) + EPS)
    return (y * gain.astype(jnp.float32)).astype(x.dtype)


def modulate(x, gain, shift, scale):
    return rms_norm(x, gain) * (1.0 + scale[:, None, :]) + shift[:, None, :]


def swiglu(h, w_gate, w_up, w_down):
    return (jax.nn.silu(h @ w_gate) * (h @ w_up)) @ w_down


def split_cols(u):
    out, idx = [], 0
    for size in IN_SIZES:
        out.append(u[..., idx:idx + size])
        idx += size
    return out


def t5_bucket(rel):
    half = N_BUCKETS // 2
    max_exact = half // 2
    ret = jnp.where(rel > 0, half, 0)
    n = jnp.abs(rel)
    nf = jnp.maximum(n, 1).astype(jnp.float32)
    large = max_exact + (jnp.log(nf / max_exact) / math.log(MAX_DISTANCE / max_exact)
                         * (half - max_exact)).astype(jnp.int32)
    large = jnp.minimum(large, half - 1)
    return ret + jnp.where(n < max_exact, n, large)


def diff_attention(q, k, v, rel_bias, lam, lam_init, out_gain):
    seq = q.shape[1]
    scale = DH_A ** -0.5
    outs = []
    for blk in range(seq // Q_BLOCK):
        q0, end = blk * Q_BLOCK, (blk + 1) * Q_BLOCK
        logits = jnp.einsum('bqhmd,bkhmd->bhmqk', q[:, q0:end], k[:, :end]).astype(jnp.float32) * scale
        qpos = jnp.arange(q0, end)
        kpos = jnp.arange(end)
        bias = rel_bias[t5_bucket(kpos[None, :] - qpos[:, None])].astype(jnp.float32)
        logits = logits + jnp.transpose(bias, (2, 0, 1))[None, :, None]
        visible = (kpos[None, :] // CHUNK) <= (qpos[:, None] // CHUNK)
        probs = jax.nn.softmax(jnp.where(visible, logits, -jnp.inf), axis=-1)
        weights = probs[:, :, 0] - lam * probs[:, :, 1]
        outs.append(jnp.einsum('bhqk,bkhe->bqhe', weights.astype(v.dtype), v[:, :end]))
    o = jnp.concatenate(outs, axis=1)
    return rms_norm(o, out_gain) * (1.0 - lam_init)


def chunk_gated_linear_attention(q, k, v, log_f):
    bsz, seq, heads, dk = q.shape
    dv = v.shape[-1]
    n = seq // CHUNK

    def to_chunks(t):
        return t.astype(jnp.float32).reshape(bsz, n, CHUNK, heads, t.shape[-1]).transpose(1, 0, 3, 2, 4)

    qc, kc, vc, gc = to_chunks(q), to_chunks(k), to_chunks(v), to_chunks(log_f)
    causal = jnp.tril(jnp.ones((CHUNK, CHUNK), dtype=bool))

    def step(state, inp):
        qi, ki, vi, gi = inp
        b = jnp.cumsum(gi, axis=-2)
        diff = b[..., :, None, :] - b[..., None, :, :]
        decay = jnp.exp(jnp.where(causal[:, :, None], diff, -jnp.inf))
        scores = jnp.einsum('bhtd,bhsd,bhtsd->bhts', qi, ki, decay)
        o = jnp.einsum('bhts,bhsv->bhtv', scores, vi) + jnp.einsum('bhtd,bhdv->bhtv', qi * jnp.exp(b), state)
        b_last = b[..., -1:, :]
        state = jnp.exp(b_last[..., 0, :])[..., :, None] * state + jnp.einsum(
            'bhsd,bhsv->bhdv', ki * jnp.exp(b_last - b), vi)
        return state, o

    state0 = jnp.zeros((bsz, heads, dk, dv), jnp.float32)
    _, o = lax.scan(step, state0, (qc, kc, vc, gc))
    return o.transpose(1, 0, 3, 2, 4).reshape(bsz, seq, heads, dv).astype(v.dtype)


def hybrid_mixer(h, lam_init, w_in, qk_gain, lam_vec, diff_gain, rel_bias, lb,
                 hgrn_gain, gla_w_up, gla_b, gla_gain, w_branch, w_out):
    bsz, seq = h.shape[0], h.shape[1]
    u = h @ w_in
    aq, ak, av, bq, bf, bi, bg, cq, ck, cv, cr, cgd, gate_logits = split_cols(u)

    aq = rms_norm(aq.reshape(bsz, seq, H_A, 2, DH_A), qk_gain[0])
    ak = rms_norm(ak.reshape(bsz, seq, H_A, 2, DH_A), qk_gain[1])
    lv = lam_vec.astype(jnp.float32)
    lam = jnp.exp(jnp.sum(lv[0] * lv[1])) - jnp.exp(jnp.sum(lv[2] * lv[3])) + lam_init
    ya = diff_attention(aq, ak, av.reshape(bsz, seq, H_A, 2 * DH_A), rel_bias, lam, lam_init,
                        diff_gain).reshape(bsz, seq, MIX_WIDTH)

    lb_h = lb.reshape(H_B, DK_B)
    zf = bf.reshape(bsz, seq, H_B, DK_B).astype(jnp.float32)
    log_f = jnp.logaddexp(jnp.log(lb_h), jnp.log1p(-lb_h) + jax.nn.log_sigmoid(zf))
    k_b = (1.0 - lb_h) * jax.nn.sigmoid(-zf)
    ob = chunk_gated_linear_attention(bq.reshape(bsz, seq, H_B, DK_B), k_b,
                                      bi.reshape(bsz, seq, H_B, DV_B), log_f)
    yb = rms_norm(ob * jax.nn.sigmoid(bg).reshape(bsz, seq, H_B, DV_B), hgrn_gain).reshape(bsz, seq, MIX_WIDTH)

    log_a = jax.nn.log_sigmoid((cgd @ gla_w_up + gla_b).astype(jnp.float32)) / GLA_GATE_NORM
    oc = chunk_gated_linear_attention(cq.reshape(bsz, seq, H_C, DK_C) * (DK_C ** -0.5),
                                      ck.reshape(bsz, seq, H_C, DK_C),
                                      cv.reshape(bsz, seq, H_C, DV_C),
                                      log_a.reshape(bsz, seq, H_C, DK_C))
    yc = (rms_norm(oc, gla_gain) * jax.nn.silu(cr.reshape(bsz, seq, H_C, DV_C))).reshape(bsz, seq, MIX_WIDTH)

    ys = jnp.stack([ya, yb, yc], axis=2)
    z = jnp.einsum('bsnc,ncd->bsnd', ys, w_branch)
    g = jax.nn.sigmoid(gate_logits.reshape(bsz, seq, N_BRANCH, D_MODEL))
    return jnp.sum(g * z, axis=2) @ w_out


def setup_inputs(seed: int = 0) -> dict:
    key = jax.random.key(seed)
    ks = jax.random.split(key, 20)

    def nrm(k, shape, scale):
        return jax.random.normal(k, shape, jnp.float32) * scale

    return {
        'x': nrm(ks[0], (BATCH, SEQ, D_MODEL), 1.0),
        'c': nrm(ks[1], (BATCH, D_MODEL), 1.0),
        'w_ada': nrm(ks[2], (DEPTH, D_MODEL, 9 * D_MODEL), 0.5 * D_MODEL ** -0.5),
        'b_ada': nrm(ks[3], (DEPTH, 9 * D_MODEL), 0.02),
        'norm_gains': 1.0 + nrm(ks[4], (DEPTH, 4, D_MODEL), 0.02),
        'ffn_w_gate': nrm(ks[5], (DEPTH, 2, D_MODEL, D_FF), D_MODEL ** -0.5),
        'ffn_w_up': nrm(ks[6], (DEPTH, 2, D_MODEL, D_FF), D_MODEL ** -0.5),
        'ffn_w_down': nrm(ks[7], (DEPTH, 2, D_FF, D_MODEL), D_FF ** -0.5),
        'w_in': nrm(ks[8], (DEPTH, D_MODEL, D_IN), D_MODEL ** -0.5),
        'qk_gains': 1.0 + nrm(ks[9], (DEPTH, 2, DH_A), 0.02),
        'diff_lambda': nrm(ks[10], (DEPTH, 4, DH_A), 0.1),
        'diff_out_gain': 1.0 + nrm(ks[11], (DEPTH, 2 * DH_A), 0.02),
        'rel_bias': nrm(ks[12], (N_BUCKETS, H_A), 0.5),
        'hgrn_lb_logits': nrm(ks[13], (DEPTH, H_B * DK_B), 1.0),
        'hgrn_out_gain': 1.0 + nrm(ks[14], (DEPTH, DV_B), 0.02),
        'gla_w_gate_up': nrm(ks[15], (DEPTH, GLA_GATE_RANK, H_C * DK_C), GLA_GATE_RANK ** -0.5),
        'gla_b_gate': nrm(ks[16], (DEPTH, H_C * DK_C), 0.1),
        'gla_out_gain': 1.0 + nrm(ks[17], (DEPTH, DV_C), 0.02),
        'w_branch': nrm(ks[18], (DEPTH, N_BRANCH, MIX_WIDTH, D_MODEL), MIX_WIDTH ** -0.5),
        'w_out': nrm(ks[19], (DEPTH, D_MODEL, D_MODEL), D_MODEL ** -0.5),
    }


def reference(x, c, w_ada, b_ada, norm_gains, ffn_w_gate, ffn_w_up, ffn_w_down, w_in,
              qk_gains, diff_lambda, diff_out_gain, rel_bias, hgrn_lb_logits, hgrn_out_gain,
              gla_w_gate_up, gla_b_gate, gla_out_gain, w_branch, w_out):
    lb_all = jnp.cumsum(jax.nn.softmax(hgrn_lb_logits.astype(jnp.float32), axis=0), axis=0)
    lb_all = lb_all - lb_all[0]
    cond = jax.nn.silu(c)
    bsz = c.shape[0]
    for l in range(DEPTH):
        mod = (cond @ w_ada[l] + b_ada[l]).reshape(bsz, 3, 3, D_MODEL)
        shift, scale, gate = mod[:, :, 0], mod[:, :, 1], mod[:, :, 2]
        lam_init = 0.8 - 0.6 * math.exp(-0.3 * l)

        h = modulate(x, norm_gains[l, 0], shift[:, 0], scale[:, 0])
        x = x + 0.5 * gate[:, 0, None, :] * swiglu(h, ffn_w_gate[l, 0], ffn_w_up[l, 0], ffn_w_down[l, 0])

        h = modulate(x, norm_gains[l, 1], shift[:, 1], scale[:, 1])
        x = x + gate[:, 1, None, :] * hybrid_mixer(
            h, lam_init, w_in[l], qk_gains[l], diff_lambda[l], diff_out_gain[l], rel_bias,
            lb_all[l], hgrn_out_gain[l], gla_w_gate_up[l], gla_b_gate[l], gla_out_gain[l],
            w_branch[l], w_out[l])

        h = modulate(x, norm_gains[l, 2], shift[:, 2], scale[:, 2])
        x = x + 0.5 * gate[:, 2, None, :] * swiglu(h, ffn_w_gate[l, 1], ffn_w_up[l, 1], ffn_w_down[l, 1])

        x = rms_norm(x, norm_gains[l, 3])
    return x
```

```cpp
#include <hip/hip_runtime.h>
#include <cstdio>
#include <cstdint>

#define GAS __attribute__((address_space(1)))
#define LAS __attribute__((address_space(3)))
typedef unsigned short bf16;
typedef short bf16x8 __attribute__((ext_vector_type(8)));
typedef float f32x4 __attribute__((ext_vector_type(4)));
typedef float f32x16 __attribute__((ext_vector_type(16)));
typedef unsigned u32x4 __attribute__((ext_vector_type(4)));
typedef unsigned u32x2 __attribute__((ext_vector_type(2)));
typedef short s16x4 __attribute__((ext_vector_type(4)));
typedef short v4i16_t __attribute__((ext_vector_type(4)));
typedef _Float16 h16x8 __attribute__((ext_vector_type(8)));

constexpr int D = 2048, NBATCH = 8, SEQ = 4096, M = NBATCH * SEQ, FF = 5632, NIN = 16400, NWIN = 16384, MIXW = 1024;
constexpr int MH = M / 2;
constexpr int NMOD = 9 * D;
constexpr float EPS = 1e-6f;
constexpr float LOG2E = 1.4426950408889634f;

constexpr size_t MiB = 1u << 20;
constexpr size_t WS_CTL = 0, CTL_ZERO_BYTES = 1 * MiB;
constexpr size_t WS_MOD = 1 * MiB;
constexpr size_t SZ_WGU = (size_t)2 * FF * D * 2, SZ_WD = (size_t)D * FF * 2, SZ_WIN = (size_t)NWIN * D * 2, SZ_WB = (size_t)3 * D * MIXW * 2, SZ_WO = (size_t)D * D * 2;
constexpr size_t WS_WGU = 4 * MiB;
constexpr size_t WS_WD = WS_WGU + 4 * SZ_WGU;
constexpr size_t WS_WIN = WS_WD + 4 * SZ_WD;
constexpr size_t WS_WB = WS_WIN + 2 * SZ_WIN;
constexpr size_t WS_WO = WS_WB + 2 * SZ_WB;
constexpr size_t WS_H = WS_WO + 2 * SZ_WO;
constexpr size_t WS_AR = WS_H + (size_t)M * D * 2;
constexpr size_t SZ_UA = (size_t)MH * 3072 * 2, SZ_UB = (size_t)MH * 4096 * 2, SZ_UC = (size_t)MH * 3584 * 2, SZ_UG = (size_t)MH * 6144 * 2, SZ_Y = (size_t)MH * 3072 * 2;
constexpr size_t WS_UA = WS_AR, WS_UB = WS_UA + SZ_UA, WS_UC = WS_UB + SZ_UB, WS_UG = WS_UC + SZ_UC, WS_Y = WS_UG + SZ_UG,
    WS_DB = WS_Y + SZ_Y, WS_DC = WS_DB + (size_t)(MH / 16) * 1024 * 4, WS_XH = WS_DC + (size_t)(MH / 16) * 512 * 4, WS_WLR = WS_XH + (size_t)M * D * 2, WS_LR = WS_WLR + (size_t)2 * 16 * D * 2, WS_END = WS_LR + (size_t)2 * M * 16 * 4;
constexpr size_t WS_ACT = WS_AR;
static_assert(WS_ACT + (size_t)M * FF * 2 <= WS_END, "act fits in the arena");
static_assert(WS_END <= (size_t)1400 * MiB, "workspace budget");
constexpr int CW_BAR = 4096;
constexpr int CW_QUEUE = 16384;

constexpr int RING_BYTES = 139264;
constexpr int LDSCTL_OFF = RING_BYTES, MISC_OFF = LDSCTL_OFF + 320;
constexpr int LDS_BYTES = 147456;

__device__ __forceinline__ unsigned cvt_pk_bf16(float lo, float hi) { unsigned r; asm volatile("v_cvt_pk_bf16_f32 %0, %1, %2" : "=v"(r) : "v"(lo), "v"(hi)); return r; }
__device__ __forceinline__ float bflo(unsigned w) { return __uint_as_float(w << 16); }
__device__ __forceinline__ float bfhi(unsigned w) { return __uint_as_float(w & 0xffff0000u); }
__device__ __forceinline__ void h8_to_f(const h16x8 v, f32x4& a, f32x4& b) { a = (f32x4){(float)v[0], (float)v[1], (float)v[2], (float)v[3]}; b = (f32x4){(float)v[4], (float)v[5], (float)v[6], (float)v[7]}; }
__device__ __forceinline__ h16x8 f_to_h8(const f32x4 a, const f32x4 b) { return (h16x8){(_Float16)a[0], (_Float16)a[1], (_Float16)a[2], (_Float16)a[3], (_Float16)b[0], (_Float16)b[1], (_Float16)b[2], (_Float16)b[3]}; }
__device__ __forceinline__ float wave_sum(float v) {
#pragma unroll
    for (int o = 1; o < 64; o <<= 1) v += __shfl_xor(v, o);
    return v;
}
__device__ __forceinline__ float wave_max(float v) {
#pragma unroll
    for (int o = 1; o < 64; o <<= 1) v = fmaxf(v, __shfl_xor(v, o));
    return v;
}
__device__ __forceinline__ float fast_rcp(float x) { return __builtin_amdgcn_rcpf(x); }
__device__ __forceinline__ float fast_exp2(float x) { return __builtin_amdgcn_exp2f(x); }
__device__ __forceinline__ float sigmoidf_(float x) { return fast_rcp(1.0f + fast_exp2(-x * LOG2E)); }
__device__ __forceinline__ float siluf_(float x) { return x * sigmoidf_(x); }

namespace pg8 {
constexpr int BM = 256, BK = 64, HALF = 128, HTB = HALF * BK * 2, STAGE_BYTES = 8 * HTB, NXCD = 8, WGM = 8;
__host__ __device__ __forceinline__ int lds_byte(int r, int c) { const int st = (r >> 4) * 2 + (c >> 5), rr = r & 15, cc = c & 31, ob = rr * 64 + cc * 2; return st * 1024 + (ob ^ (((ob >> 9) & 1) << 5)); }
__host__ __device__ __forceinline__ void stage_rc(int b, int& R, int& C) { const int st = b / 1024, sb = b % 1024, swz = sb ^ (((sb >> 9) & 1) << 5); R = (st >> 1) * 16 + swz / 64; C = (st & 1) * 32 + (swz % 64) / 2; }
__host__ __device__ __forceinline__ int perm32(int rho) { const int n = rho >> 4, i = rho & 15; return 8 * (i >> 2) + 4 * n + (i & 3); }

struct Unit { int pm, pn, n; };
struct Gemm { const bf16* A; const bf16* Bt; int lda, ldb, K; size_t a_nstride, b_nstride; };

struct StaticOrder {
    int nM, nN, nwg, G, c, NS;
    __device__ void init(int Mrows, int N, int G_, int c_, int NS_) { nM = Mrows / BM; nN = N / BM; nwg = nM * nN; G = G_; c = c_; NS = NS_; }
    __device__ bool next(int ii, Unit& u) const {
        const int i = ii / NS; u.n = ii - i * NS;
        const long L = (long)i * G + c; if (L >= nwg) return false;
        int wgid = (int)L; { const int q = nwg / NXCD, r = nwg % NXCD, xcd = wgid % NXCD, off = wgid / NXCD; wgid = (xcd < r ? xcd * (q + 1) : r * (q + 1) + (xcd - r) * q) + off; }
        const int nig = WGM * nN, gid = wgid / nig, fm = gid * WGM, gsz = (nM - fm) < WGM ? (nM - fm) : WGM;
        u.pm = fm + ((wgid % nig) % gsz); u.pn = (wgid % nig) / gsz; return true;
    }
};

template <class Epi>
__device__ __forceinline__ void gemm_phase(LAS unsigned char* lds, const Gemm g, const StaticOrder& S, const Epi& E, const int tid) {
    const int wid = __builtin_amdgcn_readfirstlane(tid >> 6), lane = tid & 63, wr = wid >> 2, wc = wid & 3, fr = lane & 15, fq = lane >> 4;
    const int K = g.K, nt = K / BK;
    unsigned voffA[2], voffB[2];
#pragma unroll
    for (int i = 0; i < 2; ++i) { int R, C; stage_rc(tid * 16 + i * 8192, R, C); const int Rb = Epi::PERM ? ((R & ~31) + perm32(R & 31)) : R;
        voffA[i] = (unsigned)(R * g.lda + C) * 2u; voffB[i] = (unsigned)(Rb * g.ldb + C) * 2u; }
    const size_t kstep = (size_t)(BK * 2);
    const size_t hsA = (size_t)HALF * g.lda * 2, hsB = (size_t)HALF * g.ldb * 2;
    const size_t tsA = 2 * hsA, tsB = 2 * hsB;
    const unsigned ldsw = (unsigned)wid * 1024u;
    const int aoff = lds_byte(wr * 64 + fr, fq * 8), boff = lds_byte(wc * 32 + fr, fq * 8);
#define PG8_SA(b, h) (((b) * 2 + (h)) * HTB)
#define PG8_SB(b, h) ((4 + (b) * 2 + (h)) * HTB)
#define PG8_STAGE(bufoff, gbase, voff) do { _Pragma("unroll") for (int _i = 0; _i < 2; ++_i) \
        __builtin_amdgcn_global_load_lds((const unsigned*)((const char*)(gbase) + (voff)[_i]), (LAS unsigned*)(lds + (bufoff) + ldsw + _i * 8192), 16, 0, 0); } while (0)
#define PG8_LDA(dst, b, h) do { _Pragma("unroll") for (int m = 0; m < 4; ++m) _Pragma("unroll") for (int k = 0; k < 2; ++k) dst[m][k] = *(const LAS bf16x8*)(lds + PG8_SA(b, h) + aoff + m * 2048 + k * 1024); } while (0)
#define PG8_LDB(dst, b, h) do { _Pragma("unroll") for (int n = 0; n < 2; ++n) _Pragma("unroll") for (int k = 0; k < 2; ++k) dst[n][k] = *(const LAS bf16x8*)(lds + PG8_SB(b, h) + boff + n * 2048 + k * 1024); } while (0)
#define PG8_MMA(ai, bj, At, Bt) do { __builtin_amdgcn_s_setprio(1); _Pragma("unroll") for (int m = 0; m < 4; ++m) _Pragma("unroll") for (int n = 0; n < 2; ++n) _Pragma("unroll") for (int k = 0; k < 2; ++k) \
        acc[ai][bj][m][n] = __builtin_amdgcn_mfma_f32_16x16x32_bf16(Bt[n][k], At[m][k], acc[ai][bj][m][n], 0, 0, 0); __builtin_amdgcn_s_setprio(0); } while (0)
#define PG8_WAIT_V(n) asm volatile("s_waitcnt vmcnt(" #n ")" ::: "memory")
#define PG8_WAIT_L(n) asm volatile("s_waitcnt lgkmcnt(" #n ")" ::: "memory")
#define PG8_BAR __builtin_amdgcn_s_barrier()
#define PG8_SCHED __builtin_amdgcn_sched_barrier(0)
#define PG8_APTR(u) ((const char*)(g.A + (size_t)(u).n * g.a_nstride) + (size_t)(u).pm * tsA)
#define PG8_BPTR(u) ((const char*)(g.Bt + (size_t)(u).n * g.b_nstride) + (size_t)(u).pn * tsB)
    Unit cur, nxt; int ui = 0;
    if (!S.next(0, cur)) return;
    f32x4 acc[2][2][4][2];
#pragma unroll
    for (int a = 0; a < 2; ++a)
#pragma unroll
        for (int b = 0; b < 2; ++b)
#pragma unroll
            for (int m = 0; m < 4; ++m)
#pragma unroll
                for (int n = 0; n < 2; ++n) acc[a][b][m][n] = (f32x4){0.f, 0.f, 0.f, 0.f};
    bf16x8 At[4][2], B0[2][2], B1[2][2];
    const char* cA = PG8_APTR(cur); const char* cB = PG8_BPTR(cur);
    PG8_STAGE(PG8_SB(0, 0), cB, voffB); PG8_STAGE(PG8_SB(0, 1), cB + hsB, voffB); PG8_STAGE(PG8_SA(0, 0), cA, voffA); PG8_STAGE(PG8_SA(0, 1), cA + hsA, voffA);
    if (wr == 1) PG8_BAR;
    PG8_WAIT_V(2); PG8_BAR;
    PG8_STAGE(PG8_SB(1, 0), cB + kstep, voffB); PG8_STAGE(PG8_SA(1, 0), cA + kstep, voffA); PG8_STAGE(PG8_SB(1, 1), cB + hsB + kstep, voffB);
    PG8_WAIT_V(6); PG8_BAR;
    for (;;) {
        const bool has_next = S.next(ui + 1, nxt);
        const char* nA = has_next ? PG8_APTR(nxt) : cA; const char* nB = has_next ? PG8_BPTR(nxt) : cB;
        for (int t = 0; t < nt; t += 2) {
            const bool last = (t == nt - 2);
            const char* a1 = cA + (size_t)(t + 1) * kstep;
            const char* a2 = last ? nA : cA + (size_t)(t + 2) * kstep; const char* b2 = last ? nB : cB + (size_t)(t + 2) * kstep;
            const char* a3 = a2 + kstep; const char* b3 = b2 + kstep;
            PG8_LDB(B0, 0, 0); PG8_LDB(B1, 0, 1); PG8_SCHED; PG8_LDA(At, 0, 0); PG8_STAGE(PG8_SA(1, 1), a1 + hsA, voffA);
            PG8_WAIT_V(8); PG8_WAIT_L(0); PG8_BAR; PG8_MMA(0, 0, At, B0); PG8_MMA(0, 1, At, B1); PG8_BAR; PG8_SCHED;
            PG8_LDA(At, 0, 1); PG8_STAGE(PG8_SB(0, 0), b2, voffB); PG8_STAGE(PG8_SB(0, 1), b2 + hsB, voffB); PG8_STAGE(PG8_SA(0, 0), a2, voffA);
            PG8_WAIT_V(8); PG8_WAIT_L(0); PG8_BAR; PG8_MMA(1, 0, At, B0); PG8_MMA(1, 1, At, B1); PG8_BAR; PG8_SCHED;
            PG8_LDB(B0, 1, 0); PG8_LDB(B1, 1, 1); PG8_SCHED; PG8_LDA(At, 1, 0); PG8_STAGE(PG8_SA(0, 1), a2 + hsA, voffA);
            PG8_WAIT_V(8); PG8_WAIT_L(0); PG8_BAR; PG8_MMA(0, 0, At, B0); PG8_MMA(0, 1, At, B1); PG8_BAR; PG8_SCHED;
            PG8_LDA(At, 1, 1); PG8_STAGE(PG8_SB(1, 0), b3, voffB); PG8_STAGE(PG8_SB(1, 1), b3 + hsB, voffB); PG8_STAGE(PG8_SA(1, 0), a3, voffA);
            PG8_WAIT_V(8); PG8_WAIT_L(0); PG8_BAR; PG8_MMA(1, 0, At, B0); PG8_MMA(1, 1, At, B1); PG8_BAR; PG8_SCHED;
        }
        if (wr == 0) PG8_BAR;
        E(acc, cur, wr, wc, fr, fq);
        if (!has_next) break;
        if (!(Epi::CHAIN && cur.n + 1 < S.NS)) {
#pragma unroll
        for (int a = 0; a < 2; ++a)
#pragma unroll
            for (int b = 0; b < 2; ++b)
#pragma unroll
                for (int m = 0; m < 4; ++m)
#pragma unroll
                    for (int n = 0; n < 2; ++n) acc[a][b][m][n] = (f32x4){0.f, 0.f, 0.f, 0.f};
        }
        cur = nxt; cA = nA; cB = nB; ++ui;
        if (wr == 1) PG8_BAR;
    }
    PG8_WAIT_V(0);
    PG8_BAR;
#undef PG8_SA
#undef PG8_SB
#undef PG8_STAGE
#undef PG8_LDA
#undef PG8_LDB
#undef PG8_MMA
#undef PG8_WAIT_V
#undef PG8_WAIT_L
#undef PG8_BAR
#undef PG8_SCHED
#undef PG8_APTR
#undef PG8_BPTR
}

struct EpiSwiglu {
    static constexpr bool PERM = true, CHAIN = false;
    bf16* O;
    __device__ __forceinline__ void operator()(f32x4 (&acc)[2][2][4][2], const Unit& u, int wr, int wc, int fr, int fq) const {
        const int row0 = u.pm * BM + wr * 64 + fr, col0 = u.pn * 128 + wc * 32 + 8 * fq;
#pragma unroll
        for (int ai = 0; ai < 2; ++ai)
#pragma unroll
            for (int m = 0; m < 4; ++m) {
                bf16* rowp = O + (size_t)(row0 + ai * HALF + m * 16) * FF + col0;
                const f32x4 g0 = acc[ai][0][m][0], g1 = acc[ai][0][m][1], u0 = acc[ai][1][m][0], u1 = acc[ai][1][m][1];
                u32x4 w;
                w.x = cvt_pk_bf16(siluf_(g0[0]) * u0[0], siluf_(g0[1]) * u0[1]); w.y = cvt_pk_bf16(siluf_(g0[2]) * u0[2], siluf_(g0[3]) * u0[3]);
                w.z = cvt_pk_bf16(siluf_(g1[0]) * u1[0], siluf_(g1[1]) * u1[1]); w.w = cvt_pk_bf16(siluf_(g1[2]) * u1[2], siluf_(g1[3]) * u1[3]);
                __builtin_nontemporal_store(w, (u32x4*)rowp);
            }
    }
};
struct EpiResid {
    static constexpr bool PERM = true, CHAIN = false;
    const float* base32; _Float16* xh; const float* gate; float coef; int row_off;
    __device__ __forceinline__ void operator()(f32x4 (&acc)[2][2][4][2], const Unit& u, int wr, int wc, int fr, int fq) const {
        const int lrow0 = row_off + u.pm * BM + wr * 64 + fr, col0 = u.pn * BM + wc * 32 + 8 * fq;
        const int b = (row_off + u.pm * BM) >> 12;
        const float* gp = gate + (size_t)b * NMOD + col0;
        f32x4 gv[2][2];
#pragma unroll
        for (int bj = 0; bj < 2; ++bj)
#pragma unroll
            for (int n = 0; n < 2; ++n) gv[bj][n] = *(const f32x4*)(gp + bj * HALF + 4 * n) * coef;
        _Float16* xp = xh + (size_t)lrow0 * D + col0;
        if (base32) {
            const float* bp = base32 + (size_t)lrow0 * D + col0;
#pragma unroll
            for (int am = 0; am < 8; am += 2) {
                f32x4 xb[2][2][2];
#pragma unroll
                for (int mm = 0; mm < 2; ++mm)
#pragma unroll
                    for (int bj = 0; bj < 2; ++bj) { const int ai = (am + mm) >> 2, m = (am + mm) & 3; const float* p = bp + (size_t)(ai * HALF + m * 16) * D + bj * HALF; xb[mm][bj][0] = *(const f32x4*)p; xb[mm][bj][1] = *(const f32x4*)(p + 4); }
#pragma unroll
                for (int mm = 0; mm < 2; ++mm)
#pragma unroll
                    for (int bj = 0; bj < 2; ++bj) { const int ai = (am + mm) >> 2, m = (am + mm) & 3;
                        *(h16x8*)(xp + (size_t)(ai * HALF + m * 16) * D + bj * HALF) = f_to_h8(xb[mm][bj][0] + gv[bj][0] * acc[ai][bj][m][0], xb[mm][bj][1] + gv[bj][1] * acc[ai][bj][m][1]); }
                __builtin_amdgcn_sched_barrier(0);
            }
        } else {
#pragma unroll
            for (int ai = 0; ai < 2; ++ai) {
                h16x8 xv[4][2];
#pragma unroll
                for (int m = 0; m < 4; ++m)
#pragma unroll
                    for (int bj = 0; bj < 2; ++bj) xv[m][bj] = *(const h16x8*)(xp + (size_t)(ai * HALF + m * 16) * D + bj * HALF);
#pragma unroll
                for (int m = 0; m < 4; ++m)
#pragma unroll
                    for (int bj = 0; bj < 2; ++bj) { f32x4 b0, b1; h8_to_f(xv[m][bj], b0, b1);
                        *(h16x8*)(xp + (size_t)(ai * HALF + m * 16) * D + bj * HALF) = f_to_h8(b0 + gv[bj][0] * acc[ai][bj][m][0], b1 + gv[bj][1] * acc[ai][bj][m][1]); }
            }
        }
    }
};
struct EpiWin {
    static constexpr bool PERM = true, CHAIN = false;
    bf16 *UA, *UB, *UC, *UG; const float* qkg;
    __device__ __forceinline__ void operator()(f32x4 (&acc)[2][2][4][2], const Unit& u, int wr, int wc, int fr, int fq) const {
        const int row0 = u.pm * BM + wr * 64 + fr;
        if (u.pn < 8) {
            const float* gp = qkg + (u.pn < 4 ? 0 : 64) + 8 * fq; const float qs = u.pn < 4 ? 0.125f * LOG2E : 1.0f;
            f32x4 gv[2][2];
#pragma unroll
            for (int bj = 0; bj < 2; ++bj)
#pragma unroll
                for (int n = 0; n < 2; ++n) gv[bj][n] = *(const f32x4*)(gp + 32 * bj + 4 * n) * qs;
#pragma unroll
            for (int ai = 0; ai < 2; ++ai)
#pragma unroll
                for (int m = 0; m < 4; ++m) {
                    float ss = 0.f;
#pragma unroll
                    for (int bj = 0; bj < 2; ++bj)
#pragma unroll
                        for (int n = 0; n < 2; ++n) { const f32x4 v = acc[ai][bj][m][n]; ss += (v[0] * v[0] + v[1] * v[1]) + (v[2] * v[2] + v[3] * v[3]); }
                    ss += __shfl_xor(ss, 16); ss += __shfl_xor(ss, 32);
                    const float rstd = 1.0f / sqrtf(ss * (1.0f / 64.0f) + EPS);
                    bf16* rowp = UA + (size_t)(row0 + ai * HALF + m * 16) * 3072 + u.pn * 256 + 64 * wc + 8 * fq;
#pragma unroll
                    for (int bj = 0; bj < 2; ++bj) { const f32x4 v0 = acc[ai][bj][m][0] * rstd * gv[bj][0], v1 = acc[ai][bj][m][1] * rstd * gv[bj][1];
                        u32x4 w; w.x = cvt_pk_bf16(v0[0], v0[1]); w.y = cvt_pk_bf16(v0[2], v0[3]); w.z = cvt_pk_bf16(v1[0], v1[1]); w.w = cvt_pk_bf16(v1[2], v1[3]);
                        *(u32x4*)(rowp + 32 * bj) = w; }
                }
            return;
        }
        bf16* dst; int ld, c0; bool sg = false;
        if (u.pn < 12) { dst = UA; ld = 3072; c0 = u.pn * 256; }
        else if (u.pn < 28) { dst = UB; ld = 4096; c0 = (u.pn - 12) * 256; }
        else if (u.pn < 40) { dst = UC; ld = 3584; c0 = (u.pn - 28) * 256; }
        else { dst = UG; ld = 6144; c0 = (u.pn - 40) * 256; sg = true; }
        const int col0 = c0 + wc * 32 + 8 * fq;
#pragma unroll
        for (int ai = 0; ai < 2; ++ai)
#pragma unroll
            for (int m = 0; m < 4; ++m) { bf16* rowp = dst + (size_t)(row0 + ai * HALF + m * 16) * ld + col0;
#pragma unroll
                for (int bj = 0; bj < 2; ++bj) { f32x4 v0 = acc[ai][bj][m][0], v1 = acc[ai][bj][m][1];
                    if (sg) {
                        u32x2 w8; w8.x = 0u; w8.y = 0u;
#pragma unroll
                        for (int e = 0; e < 4; ++e) { w8.x = __builtin_amdgcn_cvt_pk_u8_f32(sigmoidf_(v0[e]) * 254.0f + 1.0f, e, w8.x); w8.y = __builtin_amdgcn_cvt_pk_u8_f32(sigmoidf_(v1[e]) * 254.0f + 1.0f, e, w8.y); }
                        *(u32x2*)((unsigned char*)UG + (size_t)(row0 + ai * HALF + m * 16) * 6144 + col0 + bj * HALF) = w8;
                    } else {
                    u32x4 w; w.x = cvt_pk_bf16(v0[0], v0[1]); w.y = cvt_pk_bf16(v0[2], v0[3]); w.z = cvt_pk_bf16(v1[0], v1[1]); w.w = cvt_pk_bf16(v1[2], v1[3]);
                    *(u32x4*)(rowp + bj * HALF) = w; } } }
    }
};
struct EpiMerge {
    static constexpr bool PERM = true, CHAIN = true;
    const bf16* UG; bf16* Mb;
    __device__ __forceinline__ void operator()(f32x4 (&acc)[2][2][4][2], const Unit& u, int wr, int wc, int fr, int fq) const {
        const int row0 = u.pm * BM + wr * 64 + fr, col0 = u.pn * BM + wc * 32 + 8 * fq;
        const unsigned char* gb = (const unsigned char*)UG + (size_t)row0 * 6144 + (size_t)u.n * D + col0;
        const bool mid = u.n < 2; const int doff = mid ? D : 0;
#pragma unroll
        for (int ai = 0; ai < 2; ++ai) {
            u32x2 gw[4][2], g2[4][2];
#pragma unroll
            for (int m = 0; m < 4; ++m)
#pragma unroll
                for (int bj = 0; bj < 2; ++bj) { const unsigned char* p = gb + (size_t)(ai * HALF + m * 16) * 6144 + bj * HALF; gw[m][bj] = *(const u32x2*)p; g2[m][bj] = *(const u32x2*)(p + doff); }
#pragma unroll
            for (int m = 0; m < 4; ++m)
#pragma unroll
                for (int bj = 0; bj < 2; ++bj) { const u32x2 a = gw[m][bj], c = g2[m][bj];
                    float s[8];
#pragma unroll
                    for (int e = 0; e < 8; ++e) { const float den = (float)(((e < 4 ? c.x : c.y) >> (8 * (e & 3))) & 255u);
                        s[e] = (float)(((e < 4 ? a.x : a.y) >> (8 * (e & 3))) & 255u) * fast_rcp(mid ? den : 255.0f); }
                    f32x4& v0 = acc[ai][bj][m][0]; f32x4& v1 = acc[ai][bj][m][1];
                    v0 = v0 * (f32x4){s[0], s[1], s[2], s[3]}; v1 = v1 * (f32x4){s[4], s[5], s[6], s[7]}; }
        }
        if (u.n == 2) {
            bf16* mp = Mb + (size_t)row0 * D + col0;
#pragma unroll
            for (int ai = 0; ai < 2; ++ai)
#pragma unroll
                for (int m = 0; m < 4; ++m)
#pragma unroll
                    for (int bj = 0; bj < 2; ++bj) { const f32x4 v0 = acc[ai][bj][m][0], v1 = acc[ai][bj][m][1];
                        u32x4 w; w.x = cvt_pk_bf16(v0[0], v0[1]); w.y = cvt_pk_bf16(v0[2], v0[3]); w.z = cvt_pk_bf16(v1[0], v1[1]); w.w = cvt_pk_bf16(v1[2], v1[3]);
                        *(u32x4*)(mp + (size_t)(ai * HALF + m * 16) * D + bj * HALF) = w; }
        }
    }
};
}

#define XB_TMO      128
#define XB_XCNT(j)  (256  + 64 * (j))
#define XB_XSUB(j)  (1280 + 64 * (j))
#define XB_XGEN(j)  (2304 + 64 * (j))
#define XB_TOP      3328
#define XB_TOPGEN   3392
#define XCD_BAR_WORDS 3456
#define XB_SPIN_CAP (1u << 18)
__device__ __forceinline__ unsigned xb_ld(unsigned* p)              { return __hip_atomic_load(p, __ATOMIC_RELAXED, __HIP_MEMORY_SCOPE_AGENT); }
__device__ __forceinline__ unsigned xb_add(unsigned* p, unsigned v) { return __hip_atomic_fetch_add(p, v, __ATOMIC_RELAXED, __HIP_MEMORY_SCOPE_AGENT); }
__device__ __forceinline__ unsigned xb_xcc_id() { return (unsigned)__builtin_amdgcn_s_getreg((3 << 11) | 20) & 0xFu; }
#define XB_SPIN(cond, bar) do { unsigned _sp = 0; while (cond) { __builtin_amdgcn_s_sleep(1); \
    if ((++_sp & 255u) == 0u) { if (xb_ld(&(bar)[XB_TMO])) break; if (_sp > XB_SPIN_CAP) { atomicAdd(&(bar)[XB_TMO], 1u); break; } } } } while (0)
struct XcdBarrier { unsigned* bar; unsigned x; volatile LAS unsigned* st; };
__device__ __forceinline__ XcdBarrier xcd_barrier_post(unsigned* bar, volatile LAS unsigned* st) {
    XcdBarrier b; b.bar = bar; b.x = xb_xcc_id(); b.st = st;
    if (threadIdx.x == 0) (void)xb_add(&bar[XB_XCNT(b.x)], 1u);
    return b;
}
__device__ __forceinline__ void xcd_barrier_complete(unsigned* bar, unsigned x, unsigned& nloc, unsigned& nx) {
    const unsigned G = gridDim.x * gridDim.y * gridDim.z;
    unsigned sum, cnt, mine, sp = 0u;
    for (;;) {
        sum = 0u; cnt = 0u; mine = 0u;
#pragma unroll
        for (unsigned j = 0; j < 16; ++j) { const unsigned c = xb_ld(&bar[XB_XCNT(j)]); sum += c; cnt += (c > 0u) ? 1u : 0u; mine = (j == x) ? c : mine; }
        if (sum == G) break;
        __builtin_amdgcn_s_sleep(1);
        if ((++sp & 255u) == 0u) { if (xb_ld(&bar[XB_TMO])) break; if (sp > XB_SPIN_CAP) { atomicAdd(&bar[XB_TMO], 1u); break; } }
    }
    nloc = mine > 0u ? mine : 1u; nx = cnt > 0u ? cnt : 1u;
}
__device__ __forceinline__ void xcd_barrier(const XcdBarrier& b) {
    asm volatile("s_waitcnt vmcnt(0)" ::: "memory");
    __syncthreads();
    if (threadIdx.x == 0) {
        unsigned* bar = b.bar;
        __builtin_amdgcn_s_waitcnt(0);
        unsigned nloc = b.st[0], nx = b.st[1];
        if (nloc == 0u) { xcd_barrier_complete(bar, b.x, nloc, nx); b.st[0] = nloc; b.st[1] = nx; }
        const unsigned old = xb_add(&bar[XB_XSUB(b.x)], 1u);
        const unsigned gen = old / nloc;
        if (old + 1u == (gen + 1u) * nloc) {
            __builtin_amdgcn_fence(__ATOMIC_RELEASE, "agent");
            asm volatile("s_waitcnt vmcnt(0)" ::: "memory");
            const unsigned og = xb_add(&bar[XB_TOP], 1u);
            const unsigned tg = og / nx;
            if (og + 1u == (tg + 1u) * nx) xb_add(&bar[XB_TOPGEN], 1u);
            else XB_SPIN(xb_ld(&bar[XB_TOPGEN]) == tg, bar);
            __builtin_amdgcn_fence(__ATOMIC_ACQUIRE, "agent");
            xb_add(&bar[XB_XGEN(b.x)], 1u);
            asm volatile("s_waitcnt vmcnt(0)" ::: "memory");
        } else {
            XB_SPIN(xb_ld(&bar[XB_XGEN(b.x)]) == gen, bar);
            __builtin_amdgcn_fence(__ATOMIC_ACQUIRE, "agent");
            asm volatile("s_waitcnt vmcnt(0)" ::: "memory");
        }
    }
    __syncthreads();
}

__device__ __forceinline__ void transpose_item(const float* W, size_t ldw, bf16* WT, size_t K, LAS float* scr, int lane) {
#pragma unroll 8
    for (int i = 0; i < 32; ++i) { const int kk = 2 * i + (lane >> 5); scr[kk * 33 + (lane & 31)] = W[(size_t)kk * ldw + (lane & 31)]; }
    asm volatile("s_waitcnt lgkmcnt(0)" ::: "memory");
    const int c = lane & 7;
#pragma unroll
    for (int j = 0; j < 4; ++j) { const int n = (lane >> 3) + 8 * j; const LAS float* s = scr + (8 * c) * 33 + n;
        u32x4 o; o.x = cvt_pk_bf16(s[0 * 33], s[1 * 33]); o.y = cvt_pk_bf16(s[2 * 33], s[3 * 33]); o.z = cvt_pk_bf16(s[4 * 33], s[5 * 33]); o.w = cvt_pk_bf16(s[6 * 33], s[7 * 33]);
        *(u32x4*)(WT + (size_t)n * K + 8 * c) = o; }
    asm volatile("s_waitcnt lgkmcnt(0)" ::: "memory");
}

struct In {
    const float *x, *c, *w_ada, *b_ada, *norm_gains, *w_gate, *w_up, *w_down, *w_in, *qk_gains, *diff_lambda, *diff_out_gain, *rel_bias, *lb_logits, *hgrn_gain, *gla_w_up, *gla_b, *gla_gain, *w_branch, *w_out;
};

__device__ __forceinline__ void phase_prologue(const In& in, unsigned char* ws, LAS unsigned char* lds, int tid, int wave, int lane) {
    LAS float* condT = (LAS float*)lds;
    for (int i = tid; i < NBATCH * D; i += 512) { const int b = i >> 11, k = i & 2047; condT[k * 8 + b] = siluf_(in.c[i]); }
    __syncthreads();
    float* mod = (float*)(ws + WS_MOD);
    if (wave < 3) {
        const int id = (int)blockIdx.x + 256 * wave;
        if (id < 576) {
            const int l = id / 288, cg = id % 288, col = cg * 64 + lane;
            const float* W = in.w_ada + (size_t)l * D * NMOD + col;
            float acc[8];
#pragma unroll
            for (int b = 0; b < 8; ++b) acc[b] = 0.f;
            for (int k0 = 0; k0 < D; k0 += 16) {
                float w[16];
#pragma unroll
                for (int j = 0; j < 16; ++j) w[j] = W[(size_t)(k0 + j) * NMOD];
#pragma unroll
                for (int j = 0; j < 16; ++j) { const f32x4 c0 = *(const LAS f32x4*)(condT + (k0 + j) * 8), c1 = *(const LAS f32x4*)(condT + (k0 + j) * 8 + 4);
                    acc[0] += c0[0] * w[j]; acc[1] += c0[1] * w[j]; acc[2] += c0[2] * w[j]; acc[3] += c0[3] * w[j];
                    acc[4] += c1[0] * w[j]; acc[5] += c1[1] * w[j]; acc[6] += c1[2] * w[j]; acc[7] += c1[3] * w[j]; }
            }
            const float bb = in.b_ada[(size_t)l * NMOD + col];
#pragma unroll
            for (int b = 0; b < 8; ++b) mod[((size_t)l * 8 + b) * NMOD + col] = acc[b] + bb;
        }
    }
    LAS float* scr = (LAS float*)(lds + 65536 + wave * 8704);
    static_assert(65536 + 8 * 8704 <= RING_BYTES, "prologue LDS");
    const int gw = (int)blockIdx.x * 8 + wave, NGW = (int)gridDim.x * 8;
    constexpr int I_G = (D / 64) * (FF / 32);
    constexpr int I_IN = (D / 64) * 512;
    constexpr int I_B = (MIXW / 64) * (D / 32);
    constexpr int I_O = (D / 64) * (D / 32);
    constexpr int I_F = 256;
    constexpr int PER_L = 6 * I_G + I_IN + 3 * I_B + I_O + I_F;
    for (int it = gw; it < 2 * PER_L; it += NGW) {
        const int l = it / PER_L; int r = it % PER_L;
        if (r < 6 * I_G) {
            const int which = r / I_G, q = r % I_G, j = which & 1, kind = which >> 1;
            if (kind < 2) {
                const int nblk = FF / 32, kb = q / nblk, nb = q % nblk, n0 = nb * 32, k0 = kb * 64;
                const float* W = (kind == 0 ? in.w_gate : in.w_up) + ((size_t)(l * 2 + j) * D + k0) * FF + n0;
                bf16* WT = (bf16*)(ws + WS_WGU + (size_t)(l * 2 + j) * SZ_WGU) + (size_t)(256 * (n0 >> 7) + 128 * kind + (n0 & 127)) * D + k0;
                transpose_item(W, FF, WT, D, scr, lane);
            } else {
                const int nblk = D / 32, kb = q / nblk, nb = q % nblk, n0 = nb * 32, k0 = kb * 64;
                const float* W = in.w_down + ((size_t)(l * 2 + j) * FF + k0) * D + n0;
                bf16* WT = (bf16*)(ws + WS_WD + (size_t)(l * 2 + j) * SZ_WD) + (size_t)n0 * FF + k0;
                transpose_item(W, D, WT, FF, scr, lane);
            }
            continue;
        }
        r -= 6 * I_G;
        if (r < I_IN) {
            const int kb = r / 512, nb = r % 512, k0 = kb * 64;
            const int srcc = nb < 320 ? nb * 32 : 10256 + (nb - 320) * 32;
            int dstr = nb < 320 ? nb * 32 : 10240 + (nb - 320) * 32;
            if (nb < 64) { const int r0 = (nb * 32) & 255; dstr = (nb * 32 & ~255) + 128 * ((r0 & 63) >> 5) + 32 * (r0 >> 6); }
            const float* W = in.w_in + ((size_t)l * D + k0) * NIN + srcc;
            bf16* WT = (bf16*)(ws + WS_WIN + (size_t)l * SZ_WIN) + (size_t)dstr * D + k0;
            transpose_item(W, NIN, WT, D, scr, lane);
            continue;
        }
        r -= I_IN;
        if (r < 3 * I_B) {
            const int n = r / I_B, q = r % I_B, nblk = D / 32, kb = q / nblk, nb = q % nblk, n0 = nb * 32, k0 = kb * 64;
            const float* W = in.w_branch + ((size_t)(l * 3 + n) * MIXW + k0) * D + n0;
            bf16* WT = (bf16*)(ws + WS_WB + (size_t)l * SZ_WB) + ((size_t)n * D + n0) * MIXW + k0;
            transpose_item(W, D, WT, MIXW, scr, lane);
            continue;
        }
        r -= 3 * I_B;
        if (r < I_O) {
            const int nblk = D / 32, kb = r / nblk, nb = r % nblk, n0 = nb * 32, k0 = kb * 64;
            const float* W = in.w_out + ((size_t)l * D + k0) * D + n0;
            bf16* WT = (bf16*)(ws + WS_WO + (size_t)l * SZ_WO) + (size_t)n0 * D + k0;
            transpose_item(W, D, WT, D, scr, lane);
            continue;
        }
        r -= I_O;
        {
            const int kb = r >> 3, jcb = r & 7, k = kb * 64 + lane;
            if (jcb == 0) {
                const float* wr_ = in.w_in + ((size_t)l * D + k) * NIN + 10240;
                bf16* WT = (bf16*)(ws + WS_WLR) + (size_t)l * 16 * D + k;
#pragma unroll
                for (int q = 0; q < 4; ++q) { const f32x4 t = *(const f32x4*)(wr_ + 4 * q);
#pragma unroll
                    for (int e = 0; e < 4; ++e) WT[(size_t)(4 * q + e) * D] = (bf16)(cvt_pk_bf16(t[e], 0.f) & 0xffffu); }
            }
        }
    }
}

template <int MODE, bool SRC32, bool LR = false>
__device__ __forceinline__ void phase_mod(const float* x32, _Float16* xh, float* out32, bf16* h, const float* gprev, const float* gain, const float* shiftv, const float* scalev, int wave, int lane, const bf16* wlr = nullptr, float* lrout = nullptr) {
    const int blk = (int)blockIdx.x, b = blk >> 5, r0 = blk * 128 + wave * 16;
    f32x4 A[8], Sh[8], G3[8];
#pragma unroll
    for (int k = 0; k < 8; ++k) {
        const int d = 512 * (k >> 1) + 8 * lane + 4 * (k & 1);
        if (MODE != 2) { const f32x4 g = *(const f32x4*)(gain + d), sc = *(const f32x4*)(scalev + (size_t)b * NMOD + d); A[k] = g * (sc + 1.0f); Sh[k] = *(const f32x4*)(shiftv + (size_t)b * NMOD + d); }
        if (MODE != 0) G3[k] = *(const f32x4*)(gprev + d);
    }
    for (int i = 0; i < 16; ++i) {
        const size_t ro = (size_t)(r0 + i) * D + 8 * lane;
        f32x4 v[8]; float ss = 0.f;
#pragma unroll
        for (int j = 0; j < 4; ++j) {
            if (SRC32) { v[2 * j] = *(const f32x4*)(x32 + ro + 512 * j); v[2 * j + 1] = *(const f32x4*)(x32 + ro + 512 * j + 4); }
            else h8_to_f(*(const h16x8*)(xh + ro + 512 * j), v[2 * j], v[2 * j + 1]);
        }
#pragma unroll
        for (int k = 0; k < 8; ++k) ss += (v[k][0] * v[k][0] + v[k][1] * v[k][1]) + (v[k][2] * v[k][2] + v[k][3] * v[k][3]);
        ss = wave_sum(ss);
        float rstd = 1.0f / sqrtf(ss * (1.0f / D) + EPS);
        if (MODE != 0) {
            float s2 = 0.f;
#pragma unroll
            for (int k = 0; k < 8; ++k) { v[k] = v[k] * rstd * G3[k]; s2 += (v[k][0] * v[k][0] + v[k][1] * v[k][1]) + (v[k][2] * v[k][2] + v[k][3] * v[k][3]); }
#pragma unroll
            for (int j = 0; j < 4; ++j) {
                if (MODE == 1) *(h16x8*)(xh + ro + 512 * j) = f_to_h8(v[2 * j], v[2 * j + 1]);
                else { *(f32x4*)(out32 + ro + 512 * j) = v[2 * j]; *(f32x4*)(out32 + ro + 512 * j + 4) = v[2 * j + 1]; }
            }
            if (MODE == 2) continue;
            s2 = wave_sum(s2);
            rstd = 1.0f / sqrtf(s2 * (1.0f / D) + EPS);
        }
#pragma unroll
        for (int j = 0; j < 4; ++j) { const f32x4 o0 = v[2 * j] * rstd * A[2 * j] + Sh[2 * j], o1 = v[2 * j + 1] * rstd * A[2 * j + 1] + Sh[2 * j + 1];
            u32x4 w; w.x = cvt_pk_bf16(o0[0], o0[1]); w.y = cvt_pk_bf16(o0[2], o0[3]); w.z = cvt_pk_bf16(o1[0], o1[1]); w.w = cvt_pk_bf16(o1[2], o1[3]);
            *(u32x4*)(h + ro + 512 * j) = w; }
    }
    if (LR) {
        asm volatile("s_waitcnt vmcnt(0)" ::: "memory");
        const bf16* ap = h + (size_t)(r0 + (lane & 15)) * D + 8 * (lane >> 4);
        const bf16* bp = wlr + (size_t)(lane & 15) * D + 8 * (lane >> 4);
        f32x4 acc0 = (f32x4){0.f, 0.f, 0.f, 0.f}, acc1 = (f32x4){0.f, 0.f, 0.f, 0.f};
#pragma unroll 1
        for (int k0 = 0; k0 < D; k0 += 256) {
            bf16x8 fa[8], fb[8];
#pragma unroll
            for (int q = 0; q < 8; ++q) { fa[q] = *(const bf16x8*)(ap + k0 + 32 * q); fb[q] = *(const bf16x8*)(bp + k0 + 32 * q); }
#pragma unroll
            for (int q = 0; q < 8; q += 2) { acc0 = __builtin_amdgcn_mfma_f32_16x16x32_bf16(fa[q], fb[q], acc0, 0, 0, 0); acc1 = __builtin_amdgcn_mfma_f32_16x16x32_bf16(fa[q + 1], fb[q + 1], acc1, 0, 0, 0); }
        }
        acc0 = acc0 + acc1;
#pragma unroll
        for (int i = 0; i < 4; ++i) lrout[(size_t)(r0 + 4 * (lane >> 4) + i) * 16 + (lane & 15)] = acc0[i];
    }
}

__device__ __forceinline__ void st_wt32(void* p, unsigned v) { __hip_atomic_store((unsigned*)p, v, __ATOMIC_RELAXED, __HIP_MEMORY_SCOPE_AGENT); }
__device__ __forceinline__ void st_wt128(void* p, u32x4 v) { __hip_atomic_store((unsigned long long*)p, (unsigned long long)v.x | ((unsigned long long)v.y << 32), __ATOMIC_RELAXED, __HIP_MEMORY_SCOPE_AGENT);
    __hip_atomic_store((unsigned long long*)p + 1, (unsigned long long)v.z | ((unsigned long long)v.w << 32), __ATOMIC_RELAXED, __HIP_MEMORY_SCOPE_AGENT); }
__device__ __forceinline__ void item_publish(unsigned* cnt, int tid) {
    asm volatile("s_waitcnt vmcnt(0)" ::: "memory"); __syncthreads();
    if (tid == 0) __hip_atomic_fetch_add(cnt, 1u, __ATOMIC_RELAXED, __HIP_MEMORY_SCOPE_AGENT);
}
__device__ __forceinline__ void item_wait(unsigned* cnt, unsigned want, int tid) {
    if (tid == 0) { unsigned spins = 0;
        while (__hip_atomic_load(cnt, __ATOMIC_RELAXED, __HIP_MEMORY_SCOPE_AGENT) < want) { __builtin_amdgcn_s_sleep(4); if (++spins > (1u << 22)) break; }
        __builtin_amdgcn_fence(__ATOMIC_ACQUIRE, "agent"); asm volatile("s_waitcnt vmcnt(0)" ::: "memory"); }
    __syncthreads();
}

__device__ __forceinline__ void unpack16(const u32x4 a, const u32x4 b, float (&v)[16]) {
    v[0] = bflo(a.x); v[1] = bfhi(a.x); v[2] = bflo(a.y); v[3] = bfhi(a.y); v[4] = bflo(a.z); v[5] = bfhi(a.z); v[6] = bflo(a.w); v[7] = bfhi(a.w);
    v[8] = bflo(b.x); v[9] = bfhi(b.x); v[10] = bflo(b.y); v[11] = bfhi(b.y); v[12] = bflo(b.z); v[13] = bfhi(b.z); v[14] = bflo(b.w); v[15] = bfhi(b.w);
}
__device__ __forceinline__ void pack16(const float (&v)[16], u32x4& a, u32x4& b) {
    a.x = cvt_pk_bf16(v[0], v[1]); a.y = cvt_pk_bf16(v[2], v[3]); a.z = cvt_pk_bf16(v[4], v[5]); a.w = cvt_pk_bf16(v[6], v[7]);
    b.x = cvt_pk_bf16(v[8], v[9]); b.y = cvt_pk_bf16(v[10], v[11]); b.z = cvt_pk_bf16(v[12], v[13]); b.w = cvt_pk_bf16(v[14], v[15]);
}
struct ScanBufs { float *DB, *DC; };
__device__ __forceinline__ void phase_pre(bf16* UB, bf16* UC, const ScanBufs sb, int layer, const float* lb_logits, const float* gla_b, const float* lr, const float* gup, int it0, int it_end, int it_step, int lane) {
    for (int it = it0; it < it_end; it += it_step) {
        const int ck = it / 12, sub = it - ck * 12; const size_t row0 = (size_t)ck * 16;
        {
            const int type = sub < 8 ? 0 : 1, hh = type == 0 ? sub : sub - 8, ch = hh * 128 + 2 * lane, nch = type == 0 ? 1024 : 512;
            bf16* U = type == 0 ? UB : UC; const int ld = type == 0 ? 4096 : 3584;
            bf16* qp = U + row0 * ld + ch; bf16* fp = U + row0 * ld + (type == 0 ? 1024 : 3072) + ch; bf16* kp = U + row0 * ld + (type == 0 ? 1024 : 512) + ch;
            float par[2];
#pragma unroll
            for (int e = 0; e < 2; ++e) par[e] = type == 0 ? (layer == 0 ? 0.f : 1.0f / (1.0f + __expf(lb_logits[ch + e] - lb_logits[1024 + ch + e]))) : gla_b[ch + e];
            unsigned qw[16], fw[16], kw[16];
#pragma unroll
            for (int i = 0; i < 16; ++i) { qw[i] = *(const unsigned*)(qp + (size_t)i * ld); fw[i] = type == 0 ? *(const unsigned*)(fp + (size_t)i * ld) : 0u; kw[i] = type != 0 ? *(const unsigned*)(kp + (size_t)i * ld) : 0u; }
            float qo[2][16], po[2][16]; float Dv[2];
#pragma unroll
            for (int e = 0; e < 2; ++e) {
                float P = 1.0f;
                float upw[16];
#pragma unroll
                for (int j = 0; j < 16; ++j) upw[j] = type != 0 ? gup[j * 512 + ch + e] : 0.f;
#pragma unroll
                for (int i = 0; i < 16; ++i) {
                    const float qv = e ? bfhi(qw[i]) : bflo(qw[i]); float zv = e ? bfhi(fw[i]) : bflo(fw[i]);
                    if (type != 0) { zv = 0.f;
#pragma unroll
                        for (int q = 0; q < 4; ++q) { const f32x4 t = *(const f32x4*)(lr + (row0 + i) * 16 + 4 * q); zv += (t[0] * upw[4 * q] + t[1] * upw[4 * q + 1]) + (t[2] * upw[4 * q + 2] + t[3] * upw[4 * q + 3]); } }
                    float ff, kf;
                    if (type == 0) {
                        const float en = fast_exp2(-fabsf(zv) * LOG2E);
                        const float sp = fast_rcp(1.0f + en), sn = en * sp;
                        const float s1 = zv >= 0.f ? sp : sn, s0 = zv >= 0.f ? sn : sp;
                        kf = (1.0f - par[e]) * s0; ff = par[e] + (1.0f - par[e]) * s1; qo[e][i] = qv;
                    } else {
                        const float xg = zv + par[e];
                        const float lsg = fminf(xg, 0.f) - __logf(1.0f + fast_exp2(-fabsf(xg) * LOG2E));
                        ff = fast_exp2(lsg * (LOG2E / 16.0f)); kf = e ? bfhi(kw[i]) : bflo(kw[i]); qo[e][i] = qv * 0.08838834764831845f;
                    }
                    P *= ff;
                    qo[e][i] *= P; po[e][i] = kf * fminf(fast_rcp(P), 5.5e34f);
                }
                Dv[e] = P;
            }
#pragma unroll
            for (int i = 0; i < 16; ++i) { st_wt32(qp + (size_t)i * ld, cvt_pk_bf16(qo[0][i], qo[1][i])); st_wt32(kp + (size_t)i * ld, cvt_pk_bf16(po[0][i], po[1][i])); }
            float* dp = (type == 0 ? sb.DB : sb.DC) + (size_t)ck * nch + ch;
            st_wt32(dp, __float_as_uint(Dv[0])); st_wt32(dp + 1, __float_as_uint(Dv[1]));
        }
    }
}

__device__ __forceinline__ void phase_post(const bf16* UB, const bf16* UC, bf16* Y, const float* hg  , const float* gg  , int r_0, int r_end, int r_step, int lane) {
    float g1[16], g2[16];
#pragma unroll
    for (int e = 0; e < 16; ++e) { g1[e] = hg[16 * (lane & 7) + e]; g2[e] = gg[16 * (lane & 15) + e]; }
    for (int r = r_0; r < r_end; r += r_step) {
        {
            const bf16* po = UB + (size_t)r * 4096 + 2048 + 16 * lane; const bf16* pg = UB + (size_t)r * 4096 + 3072 + 16 * lane;
            float v[16], g[16]; unpack16(*(const u32x4*)po, *(const u32x4*)(po + 8), v); unpack16(*(const u32x4*)pg, *(const u32x4*)(pg + 8), g);
            float ss = 0.f;
#pragma unroll
            for (int e = 0; e < 16; ++e) { v[e] = v[e] * sigmoidf_(g[e]); ss += v[e] * v[e]; }
            ss += __shfl_xor(ss, 1); ss += __shfl_xor(ss, 2); ss += __shfl_xor(ss, 4);
            const float rstd = 1.0f / sqrtf(ss * (1.0f / 128.0f) + EPS);
#pragma unroll
            for (int e = 0; e < 16; ++e) v[e] = v[e] * rstd * g1[e];
            u32x4 oa, ob; pack16(v, oa, ob);
            bf16* py = Y + (size_t)r * 3072 + 1024 + 16 * lane; *(u32x4*)py = oa; *(u32x4*)(py + 8) = ob;
        }
        {
            const bf16* po = UC + (size_t)r * 3584 + 1024 + 16 * lane; const bf16* pg = UC + (size_t)r * 3584 + 2048 + 16 * lane;
            float v[16], g[16]; unpack16(*(const u32x4*)po, *(const u32x4*)(po + 8), v); unpack16(*(const u32x4*)pg, *(const u32x4*)(pg + 8), g);
            float ss = 0.f;
#pragma unroll
            for (int e = 0; e < 16; ++e) ss += v[e] * v[e];
            ss += __shfl_xor(ss, 1); ss += __shfl_xor(ss, 2); ss += __shfl_xor(ss, 4); ss += __shfl_xor(ss, 8);
            const float rstd = 1.0f / sqrtf(ss * (1.0f / 256.0f) + EPS);
#pragma unroll
            for (int e = 0; e < 16; ++e) v[e] = v[e] * rstd * g2[e] * siluf_(g[e]);
            u32x4 oa, ob; pack16(v, oa, ob);
            bf16* py = Y + (size_t)r * 3072 + 2048 + 16 * lane; *(u32x4*)py = oa; *(u32x4*)(py + 8) = ob;
        }
    }
}

constexpr int AT_KROW = 272, AT_VROW = 320, AT_KBUF = 64 * AT_KROW, AT_VBUF = 64 * AT_VROW;
constexpr int AT_K = 0, AT_V = 2 * AT_KBUF, AT_TBL = AT_V + 2 * AT_VBUF, AT_L = AT_TBL + 1024, AT_END = AT_L + 8 * 128;
static_assert(AT_END <= RING_BYTES && 4 * 16384 <= AT_TBL, "attention LDS");
__device__ __forceinline__ void attn_unit(LAS unsigned char* lds, const bf16* UA, bf16* Y, int bl, int h, int qb,
                                          const float* qkg, const float* rel_bias, const float* lamv, const float* dgain, float lam_init, int tid, int wave, int lane) {
    const int i = lane & 31, hi = lane >> 5, m = wave >> 2, wq = wave & 3;
    float gqm = fabsf(qkg[lane]), gkm = fabsf(qkg[64 + lane]), bm = lane < 32 ? fabsf(rel_bias[lane * 8 + h]) : 0.f;
    gqm = wave_max(gqm); gkm = wave_max(gkm); bm = wave_max(bm);
    const float Mb = (8.0f * gqm * gkm * 1.02f + bm) * LOG2E + 1.0f;
    const float s01 = wave_sum(lamv[lane] * lamv[64 + lane]), s23 = wave_sum(lamv[128 + lane] * lamv[192 + lane]);
    const float lam = __expf(s01) - __expf(s23) + lam_init;
    const float cb_far = rel_bias[15 * 8 + h] * LOG2E - Mb;
    LAS float* tbl = (LAS float*)(lds + AT_TBL);
    if (tid < 255) { const int rel = tid - 191, n = rel < 0 ? -rel : rel;
        int bk = n < 8 ? n : (8 + (31 - __clz(n * n)) - 6); if (bk > 15) bk = 15; if (rel > 0) bk += 16;
        tbl[tid] = rel_bias[bk * 8 + h] * LOG2E; }
    const int q0 = qb * 128 + wq * 32, qc = qb * 2 + (wq >> 1);
    bf16x8 qr[4];
    { const bf16* qp = UA + (size_t)(bl * SEQ + q0 + i) * 3072 + h * 128 + m * 64 + hi * 8;
#pragma unroll
      for (int d0 = 0; d0 < 4; ++d0) qr[d0] = *(const bf16x8*)(qp + d0 * 16); }
    f32x16 O[4];
#pragma unroll
    for (int e = 0; e < 4; ++e) O[e] = (f32x16){};
    float lsum = 0.f;
    const int NT = 2 * qb + 2;
    const bf16* ksrc = UA + (size_t)(bl * SEQ) * 3072 + 1024 + h * 128;
    const bf16* vsrc = UA + (size_t)(bl * SEQ) * 3072 + 2048 + h * 128;
    u32x4 rk[2], rv[2];
#define AT_LOAD(kt) do { _Pragma("unroll") for (int j = 0; j < 2; ++j) { const int c = tid + 512 * j; \
        rk[j] = *(const u32x4*)(ksrc + (size_t)((kt) * 64 + (c >> 4)) * 3072 + (c & 15) * 8); \
        rv[j] = *(const u32x4*)(vsrc + (size_t)((kt) * 64 + (c >> 4)) * 3072 + (c & 15) * 8); } } while (0)
#define AT_STORE(buf) do { _Pragma("unroll") for (int j = 0; j < 2; ++j) { const int c = tid + 512 * j; \
        *(LAS u32x4*)(lds + AT_K + (buf) * AT_KBUF + (c >> 4) * AT_KROW + (c & 15) * 16) = rk[j]; \
        *(LAS u32x4*)(lds + AT_V + (buf) * AT_VBUF + (c >> 4) * AT_VROW + (c & 15) * 16) = rv[j]; } } while (0)
    AT_LOAD(0); AT_STORE(0);
    __syncthreads();
    const int vtr_off = (8 * hi + ((lane & 15) >> 2)) * AT_VROW + (16 * ((lane >> 4) & 1) + 4 * (lane & 3)) * 2;
    const int pi = (i & 19) | ((i & 4) << 1) | ((i & 8) >> 1);
    for (int kt = 0; kt < NT; ++kt) {
        const int buf = kt & 1;
        if (kt + 1 < NT) AT_LOAD(kt + 1);
        if (kt <= qc) {
            const bool far_ = (qc - kt) >= 3;
            const LAS unsigned char* Kb = lds + AT_K + buf * AT_KBUF;
            const LAS unsigned char* Vb = lds + AT_V + buf * AT_VBUF;
            u32x4 P[4];
            const float cinit = far_ ? cb_far : -Mb;
            f32x16 S[2];
            bf16x8 kf[2][4];
#pragma unroll
            for (int blk = 0; blk < 2; ++blk)
#pragma unroll
                for (int d0 = 0; d0 < 4; ++d0) kf[blk][d0] = *(const LAS bf16x8*)(Kb + (32 * blk + pi) * AT_KROW + m * 128 + d0 * 32 + hi * 16);
#pragma unroll
            for (int blk = 0; blk < 2; ++blk)
#pragma unroll
                for (int r = 0; r < 16; ++r) S[blk][r] = cinit;
            __builtin_amdgcn_s_setprio(1);
#pragma unroll
            for (int d0 = 0; d0 < 4; ++d0)
#pragma unroll
                for (int blk = 0; blk < 2; ++blk) S[blk] = __builtin_amdgcn_mfma_f32_32x32x16_bf16(kf[blk][d0], qr[d0], S[blk], 0, 0, 0);
            __builtin_amdgcn_s_setprio(0);
            if (!far_) {
                const int rbase = 64 * kt - (q0 + i) + 191 + 8 * hi;
#pragma unroll
                for (int blk = 0; blk < 2; ++blk)
#pragma unroll
                    for (int r = 0; r < 16; ++r) S[blk][r] += tbl[rbase + 32 * blk + 16 * (r >> 3) + (r & 7)];
            }
#pragma unroll
            for (int blk = 0; blk < 2; ++blk) {
#pragma unroll
                for (int r = 0; r < 16; ++r) { S[blk][r] = fast_exp2(S[blk][r]); lsum += S[blk][r]; }
#pragma unroll
                for (int g = 0; g < 2; ++g) { u32x4 w; w.x = cvt_pk_bf16(S[blk][8 * g + 0], S[blk][8 * g + 1]); w.y = cvt_pk_bf16(S[blk][8 * g + 2], S[blk][8 * g + 3]);
                    w.z = cvt_pk_bf16(S[blk][8 * g + 4], S[blk][8 * g + 5]); w.w = cvt_pk_bf16(S[blk][8 * g + 6], S[blk][8 * g + 7]); P[2 * blk + g] = w; }
            }
#pragma unroll
            for (int ks = 0; ks < 4; ++ks) {
                bf16x8 vf[4];
#pragma unroll
                for (int eb = 0; eb < 4; ++eb) { const LAS unsigned char* vp = Vb + vtr_off + (16 * ks) * AT_VROW + eb * 64;
                    const s16x4 lo = __builtin_bit_cast(s16x4, __builtin_amdgcn_ds_read_tr16_b64_v4i16((LAS v4i16_t*)vp)), hi4 = __builtin_bit_cast(s16x4, __builtin_amdgcn_ds_read_tr16_b64_v4i16((LAS v4i16_t*)(vp + 4 * AT_VROW)));
                    vf[eb] = (bf16x8){lo[0], lo[1], lo[2], lo[3], hi4[0], hi4[1], hi4[2], hi4[3]}; }
                __builtin_amdgcn_s_setprio(1);
#pragma unroll
                for (int eb = 0; eb < 4; ++eb) O[eb] = __builtin_amdgcn_mfma_f32_32x32x16_bf16(__builtin_bit_cast(bf16x8, P[ks]), vf[eb], O[eb], 0, 0, 0);
                __builtin_amdgcn_s_setprio(0);
                __builtin_amdgcn_sched_barrier(0);
            }
        }
        if (kt + 1 < NT) AT_STORE(buf ^ 1);
        __syncthreads();
    }
#undef AT_LOAD
#undef AT_STORE
    lsum += __shfl_xor(lsum, 32);
    LAS float* L = (LAS float*)(lds + AT_L + wave * 128);
    if (hi == 0) L[i] = (m == 0 ? 1.0f : lam) / lsum;
    asm volatile("s_waitcnt lgkmcnt(0)" ::: "memory");
    LAS float* X = (LAS float*)(lds + wq * 16384);
#pragma unroll
    for (int r = 0; r < 16; ++r) { const float sc = L[(r & 3) + 8 * (r >> 2) + 4 * hi];
#pragma unroll
        for (int eb = 0; eb < 4; ++eb) O[eb][r] *= sc; }
    if (m == 1) {
#pragma unroll
        for (int eb = 0; eb < 4; ++eb)
#pragma unroll
            for (int r = 0; r < 16; ++r) X[(eb * 16 + r) * 64 + lane] = O[eb][r];
    }
    __syncthreads();
    if (m == 0) {
        float dg[4];
#pragma unroll
        for (int eb = 0; eb < 4; ++eb) dg[eb] = dgain[32 * eb + i] * (1.0f - lam_init);
#pragma unroll
        for (int r = 0; r < 16; ++r) {
            const int q = (r & 3) + 8 * (r >> 2) + 4 * hi;
            float o[4], ss = 0.f;
#pragma unroll
            for (int eb = 0; eb < 4; ++eb) { o[eb] = O[eb][r] - X[(eb * 16 + r) * 64 + lane]; ss += o[eb] * o[eb]; }
            ss += __shfl_xor(ss, 1); ss += __shfl_xor(ss, 2); ss += __shfl_xor(ss, 4); ss += __shfl_xor(ss, 8); ss += __shfl_xor(ss, 16);
            const float rstd = 1.0f / sqrtf(ss * (1.0f / 128.0f) + EPS);
            bf16* yp = Y + (size_t)(bl * SEQ + q0 + q) * 3072 + h * 128 + i;
#pragma unroll
            for (int eb = 0; eb < 4; ++eb) yp[32 * eb] = (bf16)(cvt_pk_bf16(o[eb] * rstd * dg[eb], 0.f) & 0xffffu);
        }
    }
    __syncthreads();
}

constexpr int S2_ROW = 272;
constexpr int S2_VROW = 288;
constexpr int S2_Q = 0, S2_KP = 64 * S2_ROW, S2_VT = 2 * 64 * S2_ROW, S2_D = S2_VT + 64 * S2_VROW, S2_O = S2_D + 2048, S2_END = S2_O + 64 * S2_ROW;
static_assert(S2_END <= RING_BYTES, "scan LDS");
__device__ __forceinline__ void scan_unit(LAS unsigned char* lds, bf16* UB, bf16* UC, const ScanBufs sb, unsigned* pre_cnt, unsigned pre_want, unsigned* scan_cnt, int type, int bl, int h, int j, int tid, int wave, int lane) {
    item_wait(pre_cnt, pre_want, tid);
    const bf16 *qsrc, *psrc; const float* dsrc; bf16* vdst; int ld, nch;
    if (type == 0) { ld = 4096; nch = 1024; qsrc = UB + h * 128; psrc = UB + 1024 + h * 128; dsrc = sb.DB + h * 128; vdst = UB + 2048 + h * 128; }
    else           { ld = 3584; nch = 512;  qsrc = UC + h * 128; psrc = UC + 512 + h * 128;  dsrc = sb.DC + h * 128; vdst = UC + 1024 + h * 256 + 128 * j; }
    const size_t rowb = (size_t)bl * SEQ;
    u32x4 rq[2], rp[2], rvt[2]; float rd;
#define S2_LOAD(tb) do { const size_t r0_ = rowb + (size_t)(tb) * 64, ck0_ = r0_ >> 4; \
        _Pragma("unroll") for (int k = 0; k < 2; ++k) { const int chn = tid + 512 * k; \
            rq[k] = *(const u32x4*)(qsrc + (r0_ + (chn >> 4)) * ld + (chn & 15) * 8); rp[k] = *(const u32x4*)(psrc + (r0_ + (chn >> 4)) * ld + (chn & 15) * 8); \
            rvt[k] = *(const u32x4*)(vdst + (r0_ + (chn >> 4)) * ld + (chn & 15) * 8); } \
        rd = dsrc[(ck0_ + (tid >> 7)) * nch + (tid & 127)]; } while (0)
    f32x4 S[8];
#pragma unroll
    for (int e = 0; e < 8; ++e) S[e] = (f32x4){0.f, 0.f, 0.f, 0.f};
    const int x = lane & 15, g = lane >> 4;
    S2_LOAD(0);
    for (int tb = 0; tb < SEQ / 64; ++tb) {
#pragma unroll
        for (int k = 0; k < 2; ++k) { const int chn = tid + 512 * k;
            *(LAS u32x4*)(lds + S2_Q + (chn >> 4) * S2_ROW + (chn & 15) * 16) = rq[k]; *(LAS u32x4*)(lds + S2_KP + (chn >> 4) * S2_ROW + (chn & 15) * 16) = rp[k];
            *(LAS u32x4*)(lds + S2_VT + (chn >> 4) * S2_VROW + (chn & 15) * 16) = rvt[k]; }
        *(LAS float*)(lds + S2_D + tid * 4) = rd;
        __syncthreads();
        if (tb + 1 < SEQ / 64) S2_LOAD(tb + 1);
        s16x4 sa[4], vf[4];
#pragma unroll
        for (int cc = 0; cc < 4; ++cc) {
            const LAS unsigned char* qrow = lds + S2_Q + (16 * cc + x) * S2_ROW;
            const LAS unsigned char* prow = lds + S2_KP + (16 * cc + x) * S2_ROW;
            f32x4 st = (f32x4){0.f, 0.f, 0.f, 0.f};
#pragma unroll
            for (int i = 0; i < 4; ++i) st = __builtin_amdgcn_mfma_f32_16x16x32_bf16(*(const LAS bf16x8*)(prow + 64 * i + 16 * g), *(const LAS bf16x8*)(qrow + 64 * i + 16 * g), st, 0, 0, 0);
#pragma unroll
            for (int r = 0; r < 4; ++r) if (4 * g + r > x) st[r] = 0.f;
            const u32x2 sw = (u32x2){cvt_pk_bf16(st[0], st[1]), cvt_pk_bf16(st[2], st[3])};
            sa[cc] = __builtin_bit_cast(s16x4, sw);
            vf[cc] = __builtin_bit_cast(s16x4, __builtin_amdgcn_ds_read_tr16_b64_v4i16((LAS v4i16_t*)(lds + S2_VT + (16 * cc + 4 * g + (x >> 2)) * S2_VROW + (16 * wave + 4 * (x & 3)) * 2)));
        }
        u32x2 qa[2][8];
#define S2_FETCH(cc, bufi) do { const LAS unsigned char* qrow_ = lds + S2_Q + (16 * (cc) + x) * S2_ROW; \
            _Pragma("unroll") for (int i = 0; i < 4; ++i) { qa[bufi][2 * i] = *(const LAS u32x2*)(qrow_ + 64 * i + 8 * g); qa[bufi][2 * i + 1] = *(const LAS u32x2*)(qrow_ + 64 * i + 32 + 8 * g); } } while (0)
        S2_FETCH(0, 0);
#pragma unroll
        for (int cc = 0; cc < 4; ++cc) {
            const int bi = cc & 1;
            f32x4 dv[8]; s16x4 ka[8];
#pragma unroll
            for (int rb = 0; rb < 8; ++rb) { dv[rb] = *(const LAS f32x4*)(lds + S2_D + (cc * 128 + 16 * rb + 4 * g) * 4); ka[rb] = __builtin_bit_cast(s16x4, __builtin_amdgcn_ds_read_tr16_b64_v4i16((LAS v4i16_t*)(lds + S2_KP + (16 * cc + 4 * g + (x >> 2)) * S2_ROW + (16 * rb + 4 * (x & 3)) * 2))); }
            if (cc < 3) { if (bi == 0) S2_FETCH(cc + 1, 1); else S2_FETCH(cc + 1, 0); }
            f32x4 o0 = (f32x4){0.f, 0.f, 0.f, 0.f}, o1 = (f32x4){0.f, 0.f, 0.f, 0.f};
#pragma unroll
            for (int i = 0; i < 4; ++i) {
                const u32x4 sfw = (u32x4){cvt_pk_bf16(S[2 * i][0], S[2 * i][1]), cvt_pk_bf16(S[2 * i][2], S[2 * i][3]), cvt_pk_bf16(S[2 * i + 1][0], S[2 * i + 1][1]), cvt_pk_bf16(S[2 * i + 1][2], S[2 * i + 1][3])};
                const u32x4 qaw = (u32x4){qa[bi][2 * i].x, qa[bi][2 * i].y, qa[bi][2 * i + 1].x, qa[bi][2 * i + 1].y};
                if (i & 1) o1 = __builtin_amdgcn_mfma_f32_16x16x32_bf16(__builtin_bit_cast(bf16x8, qaw), __builtin_bit_cast(bf16x8, sfw), o1, 0, 0, 0);
                else       o0 = __builtin_amdgcn_mfma_f32_16x16x32_bf16(__builtin_bit_cast(bf16x8, qaw), __builtin_bit_cast(bf16x8, sfw), o0, 0, 0, 0);
            }
#pragma unroll
            for (int rb = 0; rb < 8; ++rb) S[rb] = __builtin_amdgcn_mfma_f32_16x16x16bf16_1k(ka[rb], vf[cc], S[rb], 0, 0, 0) * dv[rb];
            o0 = __builtin_amdgcn_mfma_f32_16x16x16bf16_1k(sa[cc], vf[cc], o0, 0, 0, 0);
            o0 = o0 + o1;
#pragma unroll
            for (int r = 0; r < 4; ++r) *(LAS unsigned short*)(lds + S2_O + (16 * cc + 4 * g + r) * S2_ROW + (16 * wave + x) * 2) = (unsigned short)(cvt_pk_bf16(o0[r], 0.f) & 0xffffu);
        }
#undef S2_FETCH
        __syncthreads();
#pragma unroll
        for (int k = 0; k < 2; ++k) { const int ch = tid + 512 * k, row = ch >> 4, c16 = ch & 15;
            st_wt128(vdst + (rowb + (size_t)tb * 64 + row) * ld + c16 * 8, *(const LAS u32x4*)(lds + S2_O + row * S2_ROW + c16 * 16)); }
    }
#undef S2_LOAD
    item_publish(scan_cnt, tid);
}

#ifndef PROBE
#define PROBE 0
#endif
#ifndef MK_PER_PHASE
#define MK_PER_PHASE 0
#endif
constexpr int NPH_LAYER = 14, NPH = 1 + 2 * NPH_LAYER + 1;
struct Args { const float* in[20]; float* out; unsigned char* ws; int ph_lo, ph_hi, li, pad; };

__global__ void __launch_bounds__(512, 2) fwd(Args a) {
    extern __shared__ __attribute__((aligned(16))) unsigned char lds_[];
    LAS unsigned char* lds = (LAS unsigned char*)lds_;
    const int tid = threadIdx.x, lane = tid & 63, wave = __builtin_amdgcn_readfirstlane(tid >> 6);
    const int G = (int)gridDim.x, blk = (int)blockIdx.x;
    for (int u = tid; u < (LDS_BYTES - LDSCTL_OFF) / 4; u += 512) ((LAS unsigned*)(lds + LDSCTL_OFF))[u] = 0u;
    __syncthreads();
    volatile LAS unsigned* MISC = (volatile LAS unsigned*)(lds + MISC_OFF);
    unsigned char* ws = a.ws;
    unsigned* ctl = (unsigned*)(ws + WS_CTL);
    const int lo = a.ph_lo, hi = a.ph_hi;
    XcdBarrier bar; bar.bar = ctl + CW_BAR; bar.x = 0; bar.st = nullptr;
    if (hi - lo > 1) bar = xcd_barrier_post(ctl + CW_BAR + a.li * XCD_BAR_WORDS, MISC + 8);
    In in;
    in.x = a.in[0]; in.c = a.in[1]; in.w_ada = a.in[2]; in.b_ada = a.in[3]; in.norm_gains = a.in[4]; in.w_gate = a.in[5]; in.w_up = a.in[6]; in.w_down = a.in[7]; in.w_in = a.in[8];
    in.qk_gains = a.in[9]; in.diff_lambda = a.in[10]; in.diff_out_gain = a.in[11]; in.rel_bias = a.in[12]; in.lb_logits = a.in[13]; in.hgrn_gain = a.in[14]; in.gla_w_up = a.in[15];
    in.gla_b = a.in[16]; in.gla_gain = a.in[17]; in.w_branch = a.in[18]; in.w_out = a.in[19];
    float* out = a.out;
    float* mod = (float*)(ws + WS_MOD);
    bf16* H = (bf16*)(ws + WS_H); bf16* ACT = (bf16*)(ws + WS_ACT);
    bf16* UA = (bf16*)(ws + WS_UA); bf16* UB = (bf16*)(ws + WS_UB); bf16* UC = (bf16*)(ws + WS_UC); bf16* UG = (bf16*)(ws + WS_UG); bf16* Y = (bf16*)(ws + WS_Y); _Float16* XH = (_Float16*)(ws + WS_XH);
    const ScanBufs sb{(float*)(ws + WS_DB), (float*)(ws + WS_DC)};
    int ph = 0;
#define IN_(k) (lo <= (k) && (k) < hi)
#define SEAM() do { if (IN_(ph) && IN_(ph + 1)) xcd_barrier(bar); ++ph; asm volatile("" : "+v"(tid_)); lane_ = tid_ & 63; wave_ = __builtin_amdgcn_readfirstlane(tid_ >> 6); } while (0)
    int tid_ = tid, lane_ = lane, wave_ = wave;
#define PBAR() do { if (hi - lo > 1) xcd_barrier(bar); asm volatile("" : "+v"(tid_)); lane_ = tid_ & 63; wave_ = __builtin_amdgcn_readfirstlane(tid_ >> 6); } while (0)

    for (int rep = 0; rep < (PROBE == 7 ? 2 : 1); ++rep) { if (rep) PBAR();
    if (IN_(ph)) phase_prologue(in, ws, lds, tid_, wave_, lane_); }
    SEAM();
    for (int l = 0; l < 2; ++l) {
        const float* modl = mod + (size_t)l * 8 * NMOD;
        const float* gains = in.norm_gains + (size_t)l * 4 * D;
        const float lam_init = l == 0 ? 0.2f : 0.35550906759f;
        if (IN_(ph)) {
            if (l == 0) phase_mod<0, true>(in.x, nullptr, nullptr, H, nullptr, gains, modl, modl + D, wave_, lane_);
            else phase_mod<1, false>(nullptr, XH, nullptr, H, in.norm_gains + (size_t)(l - 1) * 4 * D + 3 * D, gains, modl, modl + D, wave_, lane_);
        }
        SEAM();
        for (int rep = 0; rep < (PROBE == 1 ? 2 : 1); ++rep) { if (rep) PBAR();
        if (IN_(ph)) { pg8::Gemm g{H, (const bf16*)(ws + WS_WGU + (size_t)(l * 2 + 0) * SZ_WGU), D, D, D, 0, 0}; pg8::StaticOrder S; S.init(M, 2 * FF, G, blk, 1);
            pg8::EpiSwiglu E{ACT}; pg8::gemm_phase(lds, g, S, E, tid_); } }
        SEAM();
        if (IN_(ph)) { pg8::Gemm g{ACT, (const bf16*)(ws + WS_WD + (size_t)(l * 2 + 0) * SZ_WD), FF, FF, FF, 0, 0}; pg8::StaticOrder S; S.init(M, D, G, blk, 1);
            pg8::EpiResid E{l == 0 ? in.x : nullptr, XH, modl + 2 * D, 0.5f, 0}; pg8::gemm_phase(lds, g, S, E, tid_); }
        SEAM();
        for (int rep = 0; rep < (PROBE == 4 ? 2 : 1); ++rep)
        if (IN_(ph)) phase_mod<0, false, true>(nullptr, XH, nullptr, H, nullptr, gains + D, modl + 3 * D, modl + 4 * D, wave_, lane_, (const bf16*)(ws + WS_WLR) + (size_t)l * 16 * D, (float*)(ws + WS_LR) + (size_t)l * M * 16);
        SEAM();
        for (int half = 0; half < 2; ++half) {
            bf16* Hh = H + (size_t)half * MH * D;
            if (IN_(ph)) { pg8::Gemm g{Hh, (const bf16*)(ws + WS_WIN + (size_t)l * SZ_WIN), D, D, D, 0, 0}; pg8::StaticOrder S; S.init(MH, NWIN, G, blk, 1);
                pg8::EpiWin E{UA, UB, UC, UG, in.qk_gains + l * 128}; pg8::gemm_phase(lds, g, S, E, tid_);
                if (PROBE == 2) { PBAR(); pg8::gemm_phase(lds, g, S, E, tid_); } }
            SEAM();
            if (IN_(ph)) {
                constexpr int Q_PRE = 768, Q_SCAN = Q_PRE + 64, Q_ATT = Q_SCAN + 1024, Q_POST = Q_ATT + 256;
                unsigned* qh = ctl + CW_QUEUE + 64 * (l * 2 + half);
                unsigned* pre_cnt = ctl + CW_QUEUE + 64 * (8 + l * 2 + half); unsigned* scan_cnt = ctl + CW_QUEUE + 64 * (16 + l * 2 + half);
                for (;;) {
                    if (tid_ == 0) MISC[16] = __hip_atomic_fetch_add(qh, 1u, __ATOMIC_RELAXED, __HIP_MEMORY_SCOPE_AGENT);
                    __syncthreads();
                    const int item = (int)MISC[16];
                    __syncthreads();
                    if (item >= Q_POST) break;
                    int t2 = tid_; asm volatile("" : "+v"(t2)); const int l2 = t2 & 63, w2 = __builtin_amdgcn_readfirstlane(t2 >> 6);
                    if (item < Q_PRE) { phase_pre(UB, UC, sb, l, in.lb_logits, in.gla_b + l * 512, (const float*)(ws + WS_LR) + ((size_t)l * M + (size_t)half * MH) * 16, in.gla_w_up + (size_t)l * 16 * 512, item * 16 + w2, item * 16 + 16, 8, l2); item_publish(pre_cnt, t2); }
                    else if (item < Q_PRE + 32) { const int id = item - Q_PRE; scan_unit(lds, UB, UC, sb, pre_cnt, Q_PRE, scan_cnt, 0, id >> 3, id & 7, 0, t2, w2, l2); }
                    else if (item < Q_SCAN) { const int id = item - Q_PRE - 32; scan_unit(lds, UB, UC, sb, pre_cnt, Q_PRE, scan_cnt, 1, id >> 3, (id >> 1) & 3, id & 1, t2, w2, l2); }
                    else if (item < Q_ATT) { const int id = item - Q_SCAN, qb = 31 - ((id & 255) >> 3), bh = (id >> 8) * 8 + (id & 7);
                        attn_unit(lds, UA, Y, bh >> 3, bh & 7, qb, in.qk_gains + l * 128, in.rel_bias, in.diff_lambda + l * 256, in.diff_out_gain + l * 128, lam_init, t2, w2, l2); }
                    else { const int id = item - Q_ATT; item_wait(scan_cnt, 64u, t2); phase_post(UB, UC, Y, in.hgrn_gain + l * 128, in.gla_gain + l * 256, id * 64 + w2, id * 64 + 64, 8, l2); }
                }
            }
            SEAM();
            if (IN_(ph)) { pg8::Gemm g{Y, (const bf16*)(ws + WS_WB + (size_t)l * SZ_WB), 3072, MIXW, MIXW, (size_t)MIXW, (size_t)D * MIXW}; pg8::StaticOrder S; S.init(MH, D, G, blk, 3);
                pg8::EpiMerge E{UG, Hh}; pg8::gemm_phase(lds, g, S, E, tid_);
                if (PROBE == 6) { PBAR(); pg8::gemm_phase(lds, g, S, E, tid_); } }
            SEAM();
        }
        if (IN_(ph)) { pg8::Gemm g{H, (const bf16*)(ws + WS_WO + (size_t)l * SZ_WO), D, D, D, 0, 0}; pg8::StaticOrder S; S.init(M, D, G, blk, 1);
            pg8::EpiResid E{nullptr, XH, modl + 5 * D, 1.0f, 0}; pg8::gemm_phase(lds, g, S, E, tid_); }
        SEAM();
        for (int rep = 0; rep < (PROBE == 4 ? 2 : 1); ++rep)
        if (IN_(ph)) phase_mod<0, false>(nullptr, XH, nullptr, H, nullptr, gains + 2 * D, modl + 6 * D, modl + 7 * D, wave_, lane_);
        SEAM();
        for (int rep = 0; rep < (PROBE == 1 ? 2 : 1); ++rep) { if (rep) PBAR();
        if (IN_(ph)) { pg8::Gemm g{H, (const bf16*)(ws + WS_WGU + (size_t)(l * 2 + 1) * SZ_WGU), D, D, D, 0, 0}; pg8::StaticOrder S; S.init(M, 2 * FF, G, blk, 1);
            pg8::EpiSwiglu E{ACT}; pg8::gemm_phase(lds, g, S, E, tid_); } }
        SEAM();
        if (IN_(ph)) { pg8::Gemm g{ACT, (const bf16*)(ws + WS_WD + (size_t)(l * 2 + 1) * SZ_WD), FF, FF, FF, 0, 0}; pg8::StaticOrder S; S.init(M, D, G, blk, 1);
            pg8::EpiResid E{nullptr, XH, modl + 8 * D, 0.5f, 0}; pg8::gemm_phase(lds, g, S, E, tid_); }
        SEAM();
    }
    if (IN_(ph)) phase_mod<2, false>(nullptr, XH, out, nullptr, in.norm_gains + (size_t)1 * 4 * D + 3 * D, nullptr, nullptr, nullptr, wave_, lane_);
#undef IN_
#undef SEAM
#undef PBAR
}

extern "C" void kernel_launch(void* const* d_in, const int* in_sizes, int n_in, void* d_out, int out_size, void* d_ws, size_t ws_size, hipStream_t stream) {
    static int ready = 0;
    if (ready == 0) {
        if (n_in != 20 || out_size != M * D || ws_size < WS_END) { fprintf(stderr, "kernel_launch: unexpected shapes (n_in %d, out %d, ws %zu < %zu)\n", n_in, out_size, ws_size, (size_t)WS_END); ready = -1; return; }
        if (hipFuncSetAttribute((const void*)fwd, hipFuncAttributeMaxDynamicSharedMemorySize, LDS_BYTES) != hipSuccess) { fprintf(stderr, "kernel_launch: hipFuncSetAttribute failed\n"); ready = -1; return; }
        (void)hipGetLastError();
        ready = 1;
    }
    if (ready < 0) return;
    if (hipMemsetAsync((char*)d_ws + WS_CTL, 0, CTL_ZERO_BYTES, stream) != hipSuccess) return;
    Args a{};
    for (int i = 0; i < 20; ++i) a.in[i] = (const float*)d_in[i];
    a.out = (float*)d_out; a.ws = (unsigned char*)d_ws; a.li = 0; a.pad = 0;
#if MK_PER_PHASE
    for (int p = 0; p < NPH; ++p) { a.ph_lo = p; a.ph_hi = p + 1; hipLaunchKernelGGL(fwd, dim3(256), dim3(512), LDS_BYTES, stream, a); }
#else
    a.ph_lo = 0; a.ph_hi = NPH;
    hipLaunchKernelGGL(fwd, dim3(256), dim3(512), LDS_BYTES, stream, a);
#endif
}
```

```cpp
#include <hip/hip_runtime.h>
#include <cstdio>
#include <cstdint>

#define GAS __attribute__((address_space(1)))
#define LAS __attribute__((address_space(3)))
typedef unsigned short bf16;
typedef short bf16x8 __attribute__((ext_vector_type(8)));
typedef float f32x4 __attribute__((ext_vector_type(4)));
typedef float f32x16 __attribute__((ext_vector_type(16)));
typedef unsigned u32x4 __attribute__((ext_vector_type(4)));
typedef unsigned u32x2 __attribute__((ext_vector_type(2)));
typedef short s16x4 __attribute__((ext_vector_type(4)));
typedef short v4i16_t __attribute__((ext_vector_type(4)));
typedef _Float16 h16x8 __attribute__((ext_vector_type(8)));

constexpr int D = 2048, NBATCH = 8, SEQ = 4096, M = NBATCH * SEQ, FF = 5632, NIN = 16400, NWIN = 16896, MIXW = 1024;
constexpr int MH = M / 2;
constexpr int NMOD = 9 * D;
constexpr float EPS = 1e-6f;
constexpr float LOG2E = 1.4426950408889634f;

constexpr size_t MiB = 1u << 20;
constexpr size_t WS_CTL = 0, CTL_ZERO_BYTES = 1 * MiB;
constexpr size_t WS_MOD = 1 * MiB;
constexpr size_t SZ_WGU = (size_t)2 * FF * D * 2, SZ_WD = (size_t)D * FF * 2, SZ_WIN = (size_t)NWIN * D * 2, SZ_WB = (size_t)3 * D * MIXW * 2, SZ_WO = (size_t)D * D * 2;
constexpr size_t WS_WGU = 4 * MiB;
constexpr size_t WS_WD = WS_WGU + 4 * SZ_WGU;
constexpr size_t WS_WIN = WS_WD + 4 * SZ_WD;
constexpr size_t WS_WB = WS_WIN + 2 * SZ_WIN;
constexpr size_t WS_WO = WS_WB + 2 * SZ_WB;
constexpr size_t WS_H = WS_WO + 2 * SZ_WO;
constexpr size_t WS_AR = WS_H + (size_t)M * D * 2;
constexpr size_t SZ_UA = (size_t)MH * 3072 * 2, SZ_UB = (size_t)MH * 4096 * 2, SZ_UC = (size_t)MH * 3584 * 2, SZ_UG = (size_t)MH * 6144 * 2, SZ_Y = (size_t)MH * 3072 * 2;
constexpr size_t WS_UA = WS_AR, WS_UB = WS_UA + SZ_UA, WS_UC = WS_UB + SZ_UB, WS_UG = WS_UC + SZ_UC, WS_Y = WS_UG + SZ_UG,
    WS_DB = WS_Y + SZ_Y, WS_DC = WS_DB + (size_t)(MH / 16) * 1024 * 4, WS_XH = WS_DC + (size_t)(MH / 16) * 512 * 4, WS_END = WS_XH + (size_t)M * D * 2;
constexpr size_t WS_ACT = WS_AR;
static_assert(WS_ACT + (size_t)M * FF * 2 <= WS_END, "act fits in the arena");
static_assert(WS_END <= (size_t)1400 * MiB, "workspace budget");
constexpr int CW_BAR = 4096;
constexpr int CW_QUEUE = 16384;

constexpr int RING_BYTES = 139264;
constexpr int LDSCTL_OFF = RING_BYTES, MISC_OFF = LDSCTL_OFF + 320;
constexpr int LDS_BYTES = 147456;

__device__ __forceinline__ unsigned cvt_pk_bf16(float lo, float hi) { unsigned r; asm volatile("v_cvt_pk_bf16_f32 %0, %1, %2" : "=v"(r) : "v"(lo), "v"(hi)); return r; }
__device__ __forceinline__ float bflo(unsigned w) { return __uint_as_float(w << 16); }
__device__ __forceinline__ float bfhi(unsigned w) { return __uint_as_float(w & 0xffff0000u); }
__device__ __forceinline__ void h8_to_f(const h16x8 v, f32x4& a, f32x4& b) { a = (f32x4){(float)v[0], (float)v[1], (float)v[2], (float)v[3]}; b = (f32x4){(float)v[4], (float)v[5], (float)v[6], (float)v[7]}; }
__device__ __forceinline__ h16x8 f_to_h8(const f32x4 a, const f32x4 b) { return (h16x8){(_Float16)a[0], (_Float16)a[1], (_Float16)a[2], (_Float16)a[3], (_Float16)b[0], (_Float16)b[1], (_Float16)b[2], (_Float16)b[3]}; }
__device__ __forceinline__ float wave_sum(float v) {
#pragma unroll
    for (int o = 1; o < 64; o <<= 1) v += __shfl_xor(v, o);
    return v;
}
__device__ __forceinline__ float wave_max(float v) {
#pragma unroll
    for (int o = 1; o < 64; o <<= 1) v = fmaxf(v, __shfl_xor(v, o));
    return v;
}
__device__ __forceinline__ float fast_rcp(float x) { return __builtin_amdgcn_rcpf(x); }
__device__ __forceinline__ float fast_exp2(float x) { return __builtin_amdgcn_exp2f(x); }
__device__ __forceinline__ float sigmoidf_(float x) { return fast_rcp(1.0f + fast_exp2(-x * LOG2E)); }
__device__ __forceinline__ float siluf_(float x) { return x * sigmoidf_(x); }

namespace pg8 {
constexpr int BM = 256, BK = 64, HALF = 128, HTB = HALF * BK * 2, STAGE_BYTES = 8 * HTB, NXCD = 8, WGM = 8;
__host__ __device__ __forceinline__ int lds_byte(int r, int c) { const int st = (r >> 4) * 2 + (c >> 5), rr = r & 15, cc = c & 31, ob = rr * 64 + cc * 2; return st * 1024 + (ob ^ (((ob >> 9) & 1) << 5)); }
__host__ __device__ __forceinline__ void stage_rc(int b, int& R, int& C) { const int st = b / 1024, sb = b % 1024, swz = sb ^ (((sb >> 9) & 1) << 5); R = (st >> 1) * 16 + swz / 64; C = (st & 1) * 32 + (swz % 64) / 2; }
__host__ __device__ __forceinline__ int perm32(int rho) { const int n = rho >> 4, i = rho & 15; return 8 * (i >> 2) + 4 * n + (i & 3); }

struct Unit { int pm, pn, n; };
struct Gemm { const bf16* A; const bf16* Bt; int lda, ldb, K; size_t a_nstride, b_nstride; };

struct StaticOrder {
    int nM, nN, nwg, G, c, NS;
    __device__ void init(int Mrows, int N, int G_, int c_, int NS_) { nM = Mrows / BM; nN = N / BM; nwg = nM * nN; G = G_; c = c_; NS = NS_; }
    __device__ bool next(int ii, Unit& u) const {
        const int i = ii / NS; u.n = ii - i * NS;
        const long L = (long)i * G + c; if (L >= nwg) return false;
        int wgid = (int)L; { const int q = nwg / NXCD, r = nwg % NXCD, xcd = wgid % NXCD, off = wgid / NXCD; wgid = (xcd < r ? xcd * (q + 1) : r * (q + 1) + (xcd - r) * q) + off; }
        const int nig = WGM * nN, gid = wgid / nig, fm = gid * WGM, gsz = (nM - fm) < WGM ? (nM - fm) : WGM;
        u.pm = fm + ((wgid % nig) % gsz); u.pn = (wgid % nig) / gsz; return true;
    }
};

template <class Epi>
__device__ __forceinline__ void gemm_phase(LAS unsigned char* lds, const Gemm g, const StaticOrder& S, const Epi& E, const int tid) {
    const int wid = __builtin_amdgcn_readfirstlane(tid >> 6), lane = tid & 63, wr = wid >> 2, wc = wid & 3, fr = lane & 15, fq = lane >> 4;
    const int K = g.K, nt = K / BK;
    unsigned voffA[2], voffB[2];
#pragma unroll
    for (int i = 0; i < 2; ++i) { int R, C; stage_rc(tid * 16 + i * 8192, R, C); const int Rb = Epi::PERM ? ((R & ~31) + perm32(R & 31)) : R;
        voffA[i] = (unsigned)(R * g.lda + C) * 2u; voffB[i] = (unsigned)(Rb * g.ldb + C) * 2u; }
    const size_t kstep = (size_t)(BK * 2);
    const size_t hsA = (size_t)HALF * g.lda * 2, hsB = (size_t)HALF * g.ldb * 2;
    const size_t tsA = 2 * hsA, tsB = 2 * hsB;
    const unsigned ldsw = (unsigned)wid * 1024u;
    const int aoff = lds_byte(wr * 64 + fr, fq * 8), boff = lds_byte(wc * 32 + fr, fq * 8);
#define PG8_SA(b, h) (((b) * 2 + (h)) * HTB)
#define PG8_SB(b, h) ((4 + (b) * 2 + (h)) * HTB)
#define PG8_STAGE(bufoff, gbase, voff) do { _Pragma("unroll") for (int _i = 0; _i < 2; ++_i) \
        __builtin_amdgcn_global_load_lds((const unsigned*)((const char*)(gbase) + (voff)[_i]), (LAS unsigned*)(lds + (bufoff) + ldsw + _i * 8192), 16, 0, 0); } while (0)
#define PG8_LDA(dst, b, h) do { _Pragma("unroll") for (int m = 0; m < 4; ++m) _Pragma("unroll") for (int k = 0; k < 2; ++k) dst[m][k] = *(const LAS bf16x8*)(lds + PG8_SA(b, h) + aoff + m * 2048 + k * 1024); } while (0)
#define PG8_LDB(dst, b, h) do { _Pragma("unroll") for (int n = 0; n < 2; ++n) _Pragma("unroll") for (int k = 0; k < 2; ++k) dst[n][k] = *(const LAS bf16x8*)(lds + PG8_SB(b, h) + boff + n * 2048 + k * 1024); } while (0)
#define PG8_MMA(ai, bj, At, Bt) do { __builtin_amdgcn_s_setprio(1); _Pragma("unroll") for (int m = 0; m < 4; ++m) _Pragma("unroll") for (int n = 0; n < 2; ++n) _Pragma("unroll") for (int k = 0; k < 2; ++k) \
        acc[ai][bj][m][n] = __builtin_amdgcn_mfma_f32_16x16x32_bf16(Bt[n][k], At[m][k], acc[ai][bj][m][n], 0, 0, 0); __builtin_amdgcn_s_setprio(0); } while (0)
#define PG8_WAIT_V(n) asm volatile("s_waitcnt vmcnt(" #n ")" ::: "memory")
#define PG8_WAIT_L(n) asm volatile("s_waitcnt lgkmcnt(" #n ")" ::: "memory")
#define PG8_BAR __builtin_amdgcn_s_barrier()
#define PG8_SCHED __builtin_amdgcn_sched_barrier(0)
#define PG8_APTR(u) ((const char*)(g.A + (size_t)(u).n * g.a_nstride) + (size_t)(u).pm * tsA)
#define PG8_BPTR(u) ((const char*)(g.Bt + (size_t)(u).n * g.b_nstride) + (size_t)(u).pn * tsB)
    Unit cur, nxt; int ui = 0;
    if (!S.next(0, cur)) return;
    f32x4 acc[2][2][4][2];
#pragma unroll
    for (int a = 0; a < 2; ++a)
#pragma unroll
        for (int b = 0; b < 2; ++b)
#pragma unroll
            for (int m = 0; m < 4; ++m)
#pragma unroll
                for (int n = 0; n < 2; ++n) acc[a][b][m][n] = (f32x4){0.f, 0.f, 0.f, 0.f};
    bf16x8 At[4][2], B0[2][2], B1[2][2];
    const char* cA = PG8_APTR(cur); const char* cB = PG8_BPTR(cur);
    PG8_STAGE(PG8_SB(0, 0), cB, voffB); PG8_STAGE(PG8_SB(0, 1), cB + hsB, voffB); PG8_STAGE(PG8_SA(0, 0), cA, voffA); PG8_STAGE(PG8_SA(0, 1), cA + hsA, voffA);
    if (wr == 1) PG8_BAR;
    PG8_WAIT_V(2); PG8_BAR;
    PG8_STAGE(PG8_SB(1, 0), cB + kstep, voffB); PG8_STAGE(PG8_SA(1, 0), cA + kstep, voffA); PG8_STAGE(PG8_SB(1, 1), cB + hsB + kstep, voffB);
    PG8_WAIT_V(6); PG8_BAR;
    for (;;) {
        const bool has_next = S.next(ui + 1, nxt);
        const char* nA = has_next ? PG8_APTR(nxt) : cA; const char* nB = has_next ? PG8_BPTR(nxt) : cB;
        for (int t = 0; t < nt; t += 2) {
            const bool last = (t == nt - 2);
            const char* a1 = cA + (size_t)(t + 1) * kstep;
            const char* a2 = last ? nA : cA + (size_t)(t + 2) * kstep; const char* b2 = last ? nB : cB + (size_t)(t + 2) * kstep;
            const char* a3 = a2 + kstep; const char* b3 = b2 + kstep;
            PG8_LDB(B0, 0, 0); PG8_LDB(B1, 0, 1); PG8_SCHED; PG8_LDA(At, 0, 0); PG8_STAGE(PG8_SA(1, 1), a1 + hsA, voffA);
            PG8_WAIT_V(8); PG8_WAIT_L(0); PG8_BAR; PG8_MMA(0, 0, At, B0); PG8_MMA(0, 1, At, B1); PG8_BAR; PG8_SCHED;
            PG8_LDA(At, 0, 1); PG8_STAGE(PG8_SB(0, 0), b2, voffB); PG8_STAGE(PG8_SB(0, 1), b2 + hsB, voffB); PG8_STAGE(PG8_SA(0, 0), a2, voffA);
            PG8_WAIT_V(8); PG8_WAIT_L(0); PG8_BAR; PG8_MMA(1, 0, At, B0); PG8_MMA(1, 1, At, B1); PG8_BAR; PG8_SCHED;
            PG8_LDB(B0, 1, 0); PG8_LDB(B1, 1, 1); PG8_SCHED; PG8_LDA(At, 1, 0); PG8_STAGE(PG8_SA(0, 1), a2 + hsA, voffA);
            PG8_WAIT_V(8); PG8_WAIT_L(0); PG8_BAR; PG8_MMA(0, 0, At, B0); PG8_MMA(0, 1, At, B1); PG8_BAR; PG8_SCHED;
            PG8_LDA(At, 1, 1); PG8_STAGE(PG8_SB(1, 0), b3, voffB); PG8_STAGE(PG8_SB(1, 1), b3 + hsB, voffB); PG8_STAGE(PG8_SA(1, 0), a3, voffA);
            PG8_WAIT_V(8); PG8_WAIT_L(0); PG8_BAR; PG8_MMA(1, 0, At, B0); PG8_MMA(1, 1, At, B1); PG8_BAR; PG8_SCHED;
        }
        if (wr == 0) PG8_BAR;
        E(acc, cur, wr, wc, fr, fq);
        if (!has_next) break;
        if (!(Epi::CHAIN && cur.n + 1 < S.NS)) {
#pragma unroll
        for (int a = 0; a < 2; ++a)
#pragma unroll
            for (int b = 0; b < 2; ++b)
#pragma unroll
                for (int m = 0; m < 4; ++m)
#pragma unroll
                    for (int n = 0; n < 2; ++n) acc[a][b][m][n] = (f32x4){0.f, 0.f, 0.f, 0.f};
        }
        cur = nxt; cA = nA; cB = nB; ++ui;
        if (wr == 1) PG8_BAR;
    }
    PG8_WAIT_V(0);
    PG8_BAR;
#undef PG8_SA
#undef PG8_SB
#undef PG8_STAGE
#undef PG8_LDA
#undef PG8_LDB
#undef PG8_MMA
#undef PG8_WAIT_V
#undef PG8_WAIT_L
#undef PG8_BAR
#undef PG8_SCHED
#undef PG8_APTR
#undef PG8_BPTR
}

struct EpiSwiglu {
    static constexpr bool PERM = true, CHAIN = false;
    bf16* O;
    __device__ __forceinline__ void operator()(f32x4 (&acc)[2][2][4][2], const Unit& u, int wr, int wc, int fr, int fq) const {
        const int row0 = u.pm * BM + wr * 64 + fr, col0 = u.pn * 128 + wc * 32 + 8 * fq;
#pragma unroll
        for (int ai = 0; ai < 2; ++ai)
#pragma unroll
            for (int m = 0; m < 4; ++m) {
                bf16* rowp = O + (size_t)(row0 + ai * HALF + m * 16) * FF + col0;
                const f32x4 g0 = acc[ai][0][m][0], g1 = acc[ai][0][m][1], u0 = acc[ai][1][m][0], u1 = acc[ai][1][m][1];
                u32x4 w;
                w.x = cvt_pk_bf16(siluf_(g0[0]) * u0[0], siluf_(g0[1]) * u0[1]); w.y = cvt_pk_bf16(siluf_(g0[2]) * u0[2], siluf_(g0[3]) * u0[3]);
                w.z = cvt_pk_bf16(siluf_(g1[0]) * u1[0], siluf_(g1[1]) * u1[1]); w.w = cvt_pk_bf16(siluf_(g1[2]) * u1[2], siluf_(g1[3]) * u1[3]);
                __builtin_nontemporal_store(w, (u32x4*)rowp);
            }
    }
};
struct EpiResid {
    static constexpr bool PERM = true, CHAIN = false;
    const float* base32; _Float16* xh; const float* gate; float coef; int row_off;
    __device__ __forceinline__ void operator()(f32x4 (&acc)[2][2][4][2], const Unit& u, int wr, int wc, int fr, int fq) const {
        const int lrow0 = row_off + u.pm * BM + wr * 64 + fr, col0 = u.pn * BM + wc * 32 + 8 * fq;
        const int b = (row_off + u.pm * BM) >> 12;
        const float* gp = gate + (size_t)b * NMOD + col0;
        f32x4 gv[2][2];
#pragma unroll
        for (int bj = 0; bj < 2; ++bj)
#pragma unroll
            for (int n = 0; n < 2; ++n) gv[bj][n] = *(const f32x4*)(gp + bj * HALF + 4 * n) * coef;
        _Float16* xp = xh + (size_t)lrow0 * D + col0;
        if (base32) {
            const float* bp = base32 + (size_t)lrow0 * D + col0;
#pragma unroll
            for (int am = 0; am < 8; am += 2) {
                f32x4 xb[2][2][2];
#pragma unroll
                for (int mm = 0; mm < 2; ++mm)
#pragma unroll
                    for (int bj = 0; bj < 2; ++bj) { const int ai = (am + mm) >> 2, m = (am + mm) & 3; const float* p = bp + (size_t)(ai * HALF + m * 16) * D + bj * HALF; xb[mm][bj][0] = *(const f32x4*)p; xb[mm][bj][1] = *(const f32x4*)(p + 4); }
#pragma unroll
                for (int mm = 0; mm < 2; ++mm)
#pragma unroll
                    for (int bj = 0; bj < 2; ++bj) { const int ai = (am + mm) >> 2, m = (am + mm) & 3;
                        *(h16x8*)(xp + (size_t)(ai * HALF + m * 16) * D + bj * HALF) = f_to_h8(xb[mm][bj][0] + gv[bj][0] * acc[ai][bj][m][0], xb[mm][bj][1] + gv[bj][1] * acc[ai][bj][m][1]); }
                __builtin_amdgcn_sched_barrier(0);
            }
        } else {
#pragma unroll
            for (int ai = 0; ai < 2; ++ai) {
                h16x8 xv[4][2];
#pragma unroll
                for (int m = 0; m < 4; ++m)
#pragma unroll
                    for (int bj = 0; bj < 2; ++bj) xv[m][bj] = *(const h16x8*)(xp + (size_t)(ai * HALF + m * 16) * D + bj * HALF);
#pragma unroll
                for (int m = 0; m < 4; ++m)
#pragma unroll
                    for (int bj = 0; bj < 2; ++bj) { f32x4 b0, b1; h8_to_f(xv[m][bj], b0, b1);
                        *(h16x8*)(xp + (size_t)(ai * HALF + m * 16) * D + bj * HALF) = f_to_h8(b0 + gv[bj][0] * acc[ai][bj][m][0], b1 + gv[bj][1] * acc[ai][bj][m][1]); }
            }
        }
    }
};
struct EpiWin {
    static constexpr bool PERM = true, CHAIN = false;
    bf16 *UA, *UB, *UC, *UG; const float* qkg;
    __device__ __forceinline__ void operator()(f32x4 (&acc)[2][2][4][2], const Unit& u, int wr, int wc, int fr, int fq) const {
        const int row0 = u.pm * BM + wr * 64 + fr;
        if (u.pn < 8) {
            const float* gp = qkg + (u.pn < 4 ? 0 : 64) + 8 * fq; const float qs = u.pn < 4 ? 0.125f * LOG2E : 1.0f;
            f32x4 gv[2][2];
#pragma unroll
            for (int bj = 0; bj < 2; ++bj)
#pragma unroll
                for (int n = 0; n < 2; ++n) gv[bj][n] = *(const f32x4*)(gp + 32 * bj + 4 * n) * qs;
#pragma unroll
            for (int ai = 0; ai < 2; ++ai)
#pragma unroll
                for (int m = 0; m < 4; ++m) {
                    float ss = 0.f;
#pragma unroll
                    for (int bj = 0; bj < 2; ++bj)
#pragma unroll
                        for (int n = 0; n < 2; ++n) { const f32x4 v = acc[ai][bj][m][n]; ss += (v[0] * v[0] + v[1] * v[1]) + (v[2] * v[2] + v[3] * v[3]); }
                    ss += __shfl_xor(ss, 16); ss += __shfl_xor(ss, 32);
                    const float rstd = 1.0f / sqrtf(ss * (1.0f / 64.0f) + EPS);
                    bf16* rowp = UA + (size_t)(row0 + ai * HALF + m * 16) * 3072 + u.pn * 256 + 64 * wc + 8 * fq;
#pragma unroll
                    for (int bj = 0; bj < 2; ++bj) { const f32x4 v0 = acc[ai][bj][m][0] * rstd * gv[bj][0], v1 = acc[ai][bj][m][1] * rstd * gv[bj][1];
                        u32x4 w; w.x = cvt_pk_bf16(v0[0], v0[1]); w.y = cvt_pk_bf16(v0[2], v0[3]); w.z = cvt_pk_bf16(v1[0], v1[1]); w.w = cvt_pk_bf16(v1[2], v1[3]);
                        *(u32x4*)(rowp + 32 * bj) = w; }
                }
            return;
        }
        bf16* dst; int ld, c0; bool sg = false;
        if (u.pn < 12) { dst = UA; ld = 3072; c0 = u.pn * 256; }
        else if (u.pn < 28) { dst = UB; ld = 4096; c0 = (u.pn - 12) * 256; }
        else if (u.pn < 42) { dst = UC; ld = 3584; c0 = (u.pn - 28) * 256; }
        else { dst = UG; ld = 6144; c0 = (u.pn - 42) * 256; sg = true; }
        const int col0 = c0 + wc * 32 + 8 * fq;
#pragma unroll
        for (int ai = 0; ai < 2; ++ai)
#pragma unroll
            for (int m = 0; m < 4; ++m) { bf16* rowp = dst + (size_t)(row0 + ai * HALF + m * 16) * ld + col0;
#pragma unroll
                for (int bj = 0; bj < 2; ++bj) { f32x4 v0 = acc[ai][bj][m][0], v1 = acc[ai][bj][m][1];
                    if (sg) {
                        u32x2 w8; w8.x = 0u; w8.y = 0u;
#pragma unroll
                        for (int e = 0; e < 4; ++e) { w8.x = __builtin_amdgcn_cvt_pk_u8_f32(sigmoidf_(v0[e]) * 254.0f + 1.0f, e, w8.x); w8.y = __builtin_amdgcn_cvt_pk_u8_f32(sigmoidf_(v1[e]) * 254.0f + 1.0f, e, w8.y); }
                        *(u32x2*)((unsigned char*)UG + (size_t)(row0 + ai * HALF + m * 16) * 6144 + col0 + bj * HALF) = w8;
                    } else {
                    u32x4 w; w.x = cvt_pk_bf16(v0[0], v0[1]); w.y = cvt_pk_bf16(v0[2], v0[3]); w.z = cvt_pk_bf16(v1[0], v1[1]); w.w = cvt_pk_bf16(v1[2], v1[3]);
                    *(u32x4*)(rowp + bj * HALF) = w; } } }
    }
};
struct EpiMerge {
    static constexpr bool PERM = true, CHAIN = true;
    const bf16* UG; bf16* Mb;
    __device__ __forceinline__ void operator()(f32x4 (&acc)[2][2][4][2], const Unit& u, int wr, int wc, int fr, int fq) const {
        const int row0 = u.pm * BM + wr * 64 + fr, col0 = u.pn * BM + wc * 32 + 8 * fq;
        const unsigned char* gb = (const unsigned char*)UG + (size_t)row0 * 6144 + (size_t)u.n * D + col0;
        const bool mid = u.n < 2; const int doff = mid ? D : 0;
#pragma unroll
        for (int ai = 0; ai < 2; ++ai) {
            u32x2 gw[4][2], g2[4][2];
#pragma unroll
            for (int m = 0; m < 4; ++m)
#pragma unroll
                for (int bj = 0; bj < 2; ++bj) { const unsigned char* p = gb + (size_t)(ai * HALF + m * 16) * 6144 + bj * HALF; gw[m][bj] = *(const u32x2*)p; g2[m][bj] = *(const u32x2*)(p + doff); }
#pragma unroll
            for (int m = 0; m < 4; ++m)
#pragma unroll
                for (int bj = 0; bj < 2; ++bj) { const u32x2 a = gw[m][bj], c = g2[m][bj];
                    float s[8];
#pragma unroll
                    for (int e = 0; e < 8; ++e) { const float den = (float)(((e < 4 ? c.x : c.y) >> (8 * (e & 3))) & 255u);
                        s[e] = (float)(((e < 4 ? a.x : a.y) >> (8 * (e & 3))) & 255u) * fast_rcp(mid ? den : 255.0f); }
                    f32x4& v0 = acc[ai][bj][m][0]; f32x4& v1 = acc[ai][bj][m][1];
                    v0 = v0 * (f32x4){s[0], s[1], s[2], s[3]}; v1 = v1 * (f32x4){s[4], s[5], s[6], s[7]}; }
        }
        if (u.n == 2) {
            bf16* mp = Mb + (size_t)row0 * D + col0;
#pragma unroll
            for (int ai = 0; ai < 2; ++ai)
#pragma unroll
                for (int m = 0; m < 4; ++m)
#pragma unroll
                    for (int bj = 0; bj < 2; ++bj) { const f32x4 v0 = acc[ai][bj][m][0], v1 = acc[ai][bj][m][1];
                        u32x4 w; w.x = cvt_pk_bf16(v0[0], v0[1]); w.y = cvt_pk_bf16(v0[2], v0[3]); w.z = cvt_pk_bf16(v1[0], v1[1]); w.w = cvt_pk_bf16(v1[2], v1[3]);
                        *(u32x4*)(mp + (size_t)(ai * HALF + m * 16) * D + bj * HALF) = w; }
        }
    }
};
}

#define XB_TMO      128
#define XB_XCNT(j)  (256  + 64 * (j))
#define XB_XSUB(j)  (1280 + 64 * (j))
#define XB_XGEN(j)  (2304 + 64 * (j))
#define XB_TOP      3328
#define XB_TOPGEN   3392
#define XCD_BAR_WORDS 3456
#define XB_SPIN_CAP (1u << 18)
__device__ __forceinline__ unsigned xb_ld(unsigned* p)              { return __hip_atomic_load(p, __ATOMIC_RELAXED, __HIP_MEMORY_SCOPE_AGENT); }
__device__ __forceinline__ unsigned xb_add(unsigned* p, unsigned v) { return __hip_atomic_fetch_add(p, v, __ATOMIC_RELAXED, __HIP_MEMORY_SCOPE_AGENT); }
__device__ __forceinline__ unsigned xb_xcc_id() { return (unsigned)__builtin_amdgcn_s_getreg((3 << 11) | 20) & 0xFu; }
#define XB_SPIN(cond, bar) do { unsigned _sp = 0; while (cond) { __builtin_amdgcn_s_sleep(1); \
    if ((++_sp & 255u) == 0u) { if (xb_ld(&(bar)[XB_TMO])) break; if (_sp > XB_SPIN_CAP) { atomicAdd(&(bar)[XB_TMO], 1u); break; } } } } while (0)
struct XcdBarrier { unsigned* bar; unsigned x; volatile LAS unsigned* st; };
__device__ __forceinline__ XcdBarrier xcd_barrier_post(unsigned* bar, volatile LAS unsigned* st) {
    XcdBarrier b; b.bar = bar; b.x = xb_xcc_id(); b.st = st;
    if (threadIdx.x == 0) (void)xb_add(&bar[XB_XCNT(b.x)], 1u);
    return b;
}
__device__ __forceinline__ void xcd_barrier_complete(unsigned* bar, unsigned x, unsigned& nloc, unsigned& nx) {
    const unsigned G = gridDim.x * gridDim.y * gridDim.z;
    unsigned sum, cnt, mine, sp = 0u;
    for (;;) {
        sum = 0u; cnt = 0u; mine = 0u;
#pragma unroll
        for (unsigned j = 0; j < 16; ++j) { const unsigned c = xb_ld(&bar[XB_XCNT(j)]); sum += c; cnt += (c > 0u) ? 1u : 0u; mine = (j == x) ? c : mine; }
        if (sum == G) break;
        __builtin_amdgcn_s_sleep(1);
        if ((++sp & 255u) == 0u) { if (xb_ld(&bar[XB_TMO])) break; if (sp > XB_SPIN_CAP) { atomicAdd(&bar[XB_TMO], 1u); break; } }
    }
    nloc = mine > 0u ? mine : 1u; nx = cnt > 0u ? cnt : 1u;
}
__device__ __forceinline__ void xcd_barrier(const XcdBarrier& b) {
    asm volatile("s_waitcnt vmcnt(0)" ::: "memory");
    __syncthreads();
    if (threadIdx.x == 0) {
        unsigned* bar = b.bar;
        __builtin_amdgcn_s_waitcnt(0);
        unsigned nloc = b.st[0], nx = b.st[1];
        if (nloc == 0u) { xcd_barrier_complete(bar, b.x, nloc, nx); b.st[0] = nloc; b.st[1] = nx; }
        const unsigned old = xb_add(&bar[XB_XSUB(b.x)], 1u);
        const unsigned gen = old / nloc;
        if (old + 1u == (gen + 1u) * nloc) {
            __builtin_amdgcn_fence(__ATOMIC_RELEASE, "agent");
            asm volatile("s_waitcnt vmcnt(0)" ::: "memory");
            const unsigned og = xb_add(&bar[XB_TOP], 1u);
            const unsigned tg = og / nx;
            if (og + 1u == (tg + 1u) * nx) xb_add(&bar[XB_TOPGEN], 1u);
            else XB_SPIN(xb_ld(&bar[XB_TOPGEN]) == tg, bar);
            __builtin_amdgcn_fence(__ATOMIC_ACQUIRE, "agent");
            xb_add(&bar[XB_XGEN(b.x)], 1u);
            asm volatile("s_waitcnt vmcnt(0)" ::: "memory");
        } else {
            XB_SPIN(xb_ld(&bar[XB_XGEN(b.x)]) == gen, bar);
            __builtin_amdgcn_fence(__ATOMIC_ACQUIRE, "agent");
            asm volatile("s_waitcnt vmcnt(0)" ::: "memory");
        }
    }
    __syncthreads();
}

__device__ __forceinline__ void transpose_item(const float* W, size_t ldw, bf16* WT, size_t K, LAS float* scr, int lane) {
#pragma unroll 8
    for (int i = 0; i < 32; ++i) { const int kk = 2 * i + (lane >> 5); scr[kk * 33 + (lane & 31)] = W[(size_t)kk * ldw + (lane & 31)]; }
    asm volatile("s_waitcnt lgkmcnt(0)" ::: "memory");
    const int c = lane & 7;
#pragma unroll
    for (int j = 0; j < 4; ++j) { const int n = (lane >> 3) + 8 * j; const LAS float* s = scr + (8 * c) * 33 + n;
        u32x4 o; o.x = cvt_pk_bf16(s[0 * 33], s[1 * 33]); o.y = cvt_pk_bf16(s[2 * 33], s[3 * 33]); o.z = cvt_pk_bf16(s[4 * 33], s[5 * 33]); o.w = cvt_pk_bf16(s[6 * 33], s[7 * 33]);
        *(u32x4*)(WT + (size_t)n * K + 8 * c) = o; }
    asm volatile("s_waitcnt lgkmcnt(0)" ::: "memory");
}

struct In {
    const float *x, *c, *w_ada, *b_ada, *norm_gains, *w_gate, *w_up, *w_down, *w_in, *qk_gains, *diff_lambda, *diff_out_gain, *rel_bias, *lb_logits, *hgrn_gain, *gla_w_up, *gla_b, *gla_gain, *w_branch, *w_out;
};

__device__ __forceinline__ void phase_prologue(const In& in, unsigned char* ws, LAS unsigned char* lds, int tid, int wave, int lane) {
    LAS float* condT = (LAS float*)lds;
    for (int i = tid; i < NBATCH * D; i += 512) { const int b = i >> 11, k = i & 2047; condT[k * 8 + b] = siluf_(in.c[i]); }
    __syncthreads();
    float* mod = (float*)(ws + WS_MOD);
    if (wave < 3) {
        const int id = (int)blockIdx.x + 256 * wave;
        if (id < 576) {
            const int l = id / 288, cg = id % 288, col = cg * 64 + lane;
            const float* W = in.w_ada + (size_t)l * D * NMOD + col;
            float acc[8];
#pragma unroll
            for (int b = 0; b < 8; ++b) acc[b] = 0.f;
            for (int k0 = 0; k0 < D; k0 += 16) {
                float w[16];
#pragma unroll
                for (int j = 0; j < 16; ++j) w[j] = W[(size_t)(k0 + j) * NMOD];
#pragma unroll
                for (int j = 0; j < 16; ++j) { const f32x4 c0 = *(const LAS f32x4*)(condT + (k0 + j) * 8), c1 = *(const LAS f32x4*)(condT + (k0 + j) * 8 + 4);
                    acc[0] += c0[0] * w[j]; acc[1] += c0[1] * w[j]; acc[2] += c0[2] * w[j]; acc[3] += c0[3] * w[j];
                    acc[4] += c1[0] * w[j]; acc[5] += c1[1] * w[j]; acc[6] += c1[2] * w[j]; acc[7] += c1[3] * w[j]; }
            }
            const float bb = in.b_ada[(size_t)l * NMOD + col];
#pragma unroll
            for (int b = 0; b < 8; ++b) mod[((size_t)l * 8 + b) * NMOD + col] = acc[b] + bb;
        }
    }
    LAS float* scr = (LAS float*)(lds + 65536 + wave * 8704);
    static_assert(65536 + 8 * 8704 <= RING_BYTES, "prologue LDS");
    const int gw = (int)blockIdx.x * 8 + wave, NGW = (int)gridDim.x * 8;
    constexpr int I_G = (D / 64) * (FF / 32);
    constexpr int I_IN = (D / 64) * 512;
    constexpr int I_B = (MIXW / 64) * (D / 32);
    constexpr int I_O = (D / 64) * (D / 32);
    constexpr int I_F = 256;
    constexpr int PER_L = 6 * I_G + I_IN + 3 * I_B + I_O + I_F;
    for (int it = gw; it < 2 * PER_L; it += NGW) {
        const int l = it / PER_L; int r = it % PER_L;
        if (r < 6 * I_G) {
            const int which = r / I_G, q = r % I_G, j = which & 1, kind = which >> 1;
            if (kind < 2) {
                const int nblk = FF / 32, kb = q / nblk, nb = q % nblk, n0 = nb * 32, k0 = kb * 64;
                const float* W = (kind == 0 ? in.w_gate : in.w_up) + ((size_t)(l * 2 + j) * D + k0) * FF + n0;
                bf16* WT = (bf16*)(ws + WS_WGU + (size_t)(l * 2 + j) * SZ_WGU) + (size_t)(256 * (n0 >> 7) + 128 * kind + (n0 & 127)) * D + k0;
                transpose_item(W, FF, WT, D, scr, lane);
            } else {
                const int nblk = D / 32, kb = q / nblk, nb = q % nblk, n0 = nb * 32, k0 = kb * 64;
                const float* W = in.w_down + ((size_t)(l * 2 + j) * FF + k0) * D + n0;
                bf16* WT = (bf16*)(ws + WS_WD + (size_t)(l * 2 + j) * SZ_WD) + (size_t)n0 * FF + k0;
                transpose_item(W, D, WT, FF, scr, lane);
            }
            continue;
        }
        r -= 6 * I_G;
        if (r < I_IN) {
            const int kb = r / 512, nb = r % 512, k0 = kb * 64;
            const int srcc = nb < 320 ? nb * 32 : 10256 + (nb - 320) * 32;
            int dstr = nb < 320 ? nb * 32 : 10752 + (nb - 320) * 32;
            if (nb < 64) { const int r0 = (nb * 32) & 255; dstr = (nb * 32 & ~255) + 128 * ((r0 & 63) >> 5) + 32 * (r0 >> 6); }
            const float* W = in.w_in + ((size_t)l * D + k0) * NIN + srcc;
            bf16* WT = (bf16*)(ws + WS_WIN + (size_t)l * SZ_WIN) + (size_t)dstr * D + k0;
            transpose_item(W, NIN, WT, D, scr, lane);
            continue;
        }
        r -= I_IN;
        if (r < 3 * I_B) {
            const int n = r / I_B, q = r % I_B, nblk = D / 32, kb = q / nblk, nb = q % nblk, n0 = nb * 32, k0 = kb * 64;
            const float* W = in.w_branch + ((size_t)(l * 3 + n) * MIXW + k0) * D + n0;
            bf16* WT = (bf16*)(ws + WS_WB + (size_t)l * SZ_WB) + ((size_t)n * D + n0) * MIXW + k0;
            transpose_item(W, D, WT, MIXW, scr, lane);
            continue;
        }
        r -= 3 * I_B;
        if (r < I_O) {
            const int nblk = D / 32, kb = r / nblk, nb = r % nblk, n0 = nb * 32, k0 = kb * 64;
            const float* W = in.w_out + ((size_t)l * D + k0) * D + n0;
            bf16* WT = (bf16*)(ws + WS_WO + (size_t)l * SZ_WO) + (size_t)n0 * D + k0;
            transpose_item(W, D, WT, D, scr, lane);
            continue;
        }
        r -= I_O;
        {
            const int kb = r >> 3, jcb = r & 7, k = kb * 64 + lane;
            const float* wr_ = in.w_in + ((size_t)l * D + k) * NIN + 10240;
            float wv[16];
#pragma unroll
            for (int q = 0; q < 4; ++q) { const f32x4 t = *(const f32x4*)(wr_ + 4 * q); wv[4 * q] = t[0]; wv[4 * q + 1] = t[1]; wv[4 * q + 2] = t[2]; wv[4 * q + 3] = t[3]; }
            const float* up = in.gla_w_up + (size_t)l * 16 * 512 + jcb * 64;
            bf16* WT = (bf16*)(ws + WS_WIN + (size_t)l * SZ_WIN) + (size_t)(10240 + jcb * 64) * D + k;
            for (int jc = 0; jc < 64; ++jc) {
                float a = 0.f;
#pragma unroll
                for (int q = 0; q < 16; ++q) a += wv[q] * up[q * 512 + jc];
                WT[(size_t)jc * D] = (bf16)(cvt_pk_bf16(a, 0.f) & 0xffffu);
            }
        }
    }
}

template <int MODE, bool SRC32>
__device__ __forceinline__ void phase_mod(const float* x32, _Float16* xh, float* out32, bf16* h, const float* gprev, const float* gain, const float* shiftv, const float* scalev, int wave, int lane) {
    const int blk = (int)blockIdx.x, b = blk >> 5, r0 = blk * 128 + wave * 16;
    f32x4 A[8], Sh[8], G3[8];
#pragma unroll
    for (int k = 0; k < 8; ++k) {
        const int d = 512 * (k >> 1) + 8 * lane + 4 * (k & 1);
        if (MODE != 2) { const f32x4 g = *(const f32x4*)(gain + d), sc = *(const f32x4*)(scalev + (size_t)b * NMOD + d); A[k] = g * (sc + 1.0f); Sh[k] = *(const f32x4*)(shiftv + (size_t)b * NMOD + d); }
        if (MODE != 0) G3[k] = *(const f32x4*)(gprev + d);
    }
    for (int i = 0; i < 16; ++i) {
        const size_t ro = (size_t)(r0 + i) * D + 8 * lane;
        f32x4 v[8]; float ss = 0.f;
#pragma unroll
        for (int j = 0; j < 4; ++j) {
            if (SRC32) { v[2 * j] = *(const f32x4*)(x32 + ro + 512 * j); v[2 * j + 1] = *(const f32x4*)(x32 + ro + 512 * j + 4); }
            else h8_to_f(*(const h16x8*)(xh + ro + 512 * j), v[2 * j], v[2 * j + 1]);
        }
#pragma unroll
        for (int k = 0; k < 8; ++k) ss += (v[k][0] * v[k][0] + v[k][1] * v[k][1]) + (v[k][2] * v[k][2] + v[k][3] * v[k][3]);
        ss = wave_sum(ss);
        float rstd = 1.0f / sqrtf(ss * (1.0f / D) + EPS);
        if (MODE != 0) {
            float s2 = 0.f;
#pragma unroll
            for (int k = 0; k < 8; ++k) { v[k] = v[k] * rstd * G3[k]; s2 += (v[k][0] * v[k][0] + v[k][1] * v[k][1]) + (v[k][2] * v[k][2] + v[k][3] * v[k][3]); }
#pragma unroll
            for (int j = 0; j < 4; ++j) {
                if (MODE == 1) *(h16x8*)(xh + ro + 512 * j) = f_to_h8(v[2 * j], v[2 * j + 1]);
                else { *(f32x4*)(out32 + ro + 512 * j) = v[2 * j]; *(f32x4*)(out32 + ro + 512 * j + 4) = v[2 * j + 1]; }
            }
            if (MODE == 2) continue;
            s2 = wave_sum(s2);
            rstd = 1.0f / sqrtf(s2 * (1.0f / D) + EPS);
        }
#pragma unroll
        for (int j = 0; j < 4; ++j) { const f32x4 o0 = v[2 * j] * rstd * A[2 * j] + Sh[2 * j], o1 = v[2 * j + 1] * rstd * A[2 * j + 1] + Sh[2 * j + 1];
            u32x4 w; w.x = cvt_pk_bf16(o0[0], o0[1]); w.y = cvt_pk_bf16(o0[2], o0[3]); w.z = cvt_pk_bf16(o1[0], o1[1]); w.w = cvt_pk_bf16(o1[2], o1[3]);
            *(u32x4*)(h + ro + 512 * j) = w; }
    }
}

__device__ __forceinline__ void st_wt32(void* p, unsigned v) { __hip_atomic_store((unsigned*)p, v, __ATOMIC_RELAXED, __HIP_MEMORY_SCOPE_AGENT); }
__device__ __forceinline__ void st_wt128(void* p, u32x4 v) { __hip_atomic_store((unsigned long long*)p, (unsigned long long)v.x | ((unsigned long long)v.y << 32), __ATOMIC_RELAXED, __HIP_MEMORY_SCOPE_AGENT);
    __hip_atomic_store((unsigned long long*)p + 1, (unsigned long long)v.z | ((unsigned long long)v.w << 32), __ATOMIC_RELAXED, __HIP_MEMORY_SCOPE_AGENT); }
__device__ __forceinline__ void item_publish(unsigned* cnt, int tid) {
    asm volatile("s_waitcnt vmcnt(0)" ::: "memory"); __syncthreads();
    if (tid == 0) __hip_atomic_fetch_add(cnt, 1u, __ATOMIC_RELAXED, __HIP_MEMORY_SCOPE_AGENT);
}
__device__ __forceinline__ void item_wait(unsigned* cnt, unsigned want, int tid) {
    if (tid == 0) { unsigned spins = 0;
        while (__hip_atomic_load(cnt, __ATOMIC_RELAXED, __HIP_MEMORY_SCOPE_AGENT) < want) { __builtin_amdgcn_s_sleep(4); if (++spins > (1u << 22)) break; }
        __builtin_amdgcn_fence(__ATOMIC_ACQUIRE, "agent"); asm volatile("s_waitcnt vmcnt(0)" ::: "memory"); }
    __syncthreads();
}

__device__ __forceinline__ void unpack16(const u32x4 a, const u32x4 b, float (&v)[16]) {
    v[0] = bflo(a.x); v[1] = bfhi(a.x); v[2] = bflo(a.y); v[3] = bfhi(a.y); v[4] = bflo(a.z); v[5] = bfhi(a.z); v[6] = bflo(a.w); v[7] = bfhi(a.w);
    v[8] = bflo(b.x); v[9] = bfhi(b.x); v[10] = bflo(b.y); v[11] = bfhi(b.y); v[12] = bflo(b.z); v[13] = bfhi(b.z); v[14] = bflo(b.w); v[15] = bfhi(b.w);
}
__device__ __forceinline__ void pack16(const float (&v)[16], u32x4& a, u32x4& b) {
    a.x = cvt_pk_bf16(v[0], v[1]); a.y = cvt_pk_bf16(v[2], v[3]); a.z = cvt_pk_bf16(v[4], v[5]); a.w = cvt_pk_bf16(v[6], v[7]);
    b.x = cvt_pk_bf16(v[8], v[9]); b.y = cvt_pk_bf16(v[10], v[11]); b.z = cvt_pk_bf16(v[12], v[13]); b.w = cvt_pk_bf16(v[14], v[15]);
}
struct ScanBufs { float *DB, *DC; };
__device__ __forceinline__ void phase_pre(bf16* UB, bf16* UC, const ScanBufs sb, int layer, const float* lb_logits, const float* gla_b, int it0, int it_end, int it_step, int lane) {
    for (int it = it0; it < it_end; it += it_step) {
        const int ck = it / 12, sub = it - ck * 12; const size_t row0 = (size_t)ck * 16;
        {
            const int type = sub < 8 ? 0 : 1, hh = type == 0 ? sub : sub - 8, ch = hh * 128 + 2 * lane, nch = type == 0 ? 1024 : 512;
            bf16* U = type == 0 ? UB : UC; const int ld = type == 0 ? 4096 : 3584;
            bf16* qp = U + row0 * ld + ch; bf16* fp = U + row0 * ld + (type == 0 ? 1024 : 3072) + ch; bf16* kp = U + row0 * ld + (type == 0 ? 1024 : 512) + ch;
            float par[2];
#pragma unroll
            for (int e = 0; e < 2; ++e) par[e] = type == 0 ? (layer == 0 ? 0.f : 1.0f / (1.0f + __expf(lb_logits[ch + e] - lb_logits[1024 + ch + e]))) : gla_b[ch + e];
            unsigned qw[16], fw[16], kw[16];
#pragma unroll
            for (int i = 0; i < 16; ++i) { qw[i] = *(const unsigned*)(qp + (size_t)i * ld); fw[i] = *(const unsigned*)(fp + (size_t)i * ld); kw[i] = type != 0 ? *(const unsigned*)(kp + (size_t)i * ld) : 0u; }
            float qo[2][16], po[2][16]; float Dv[2];
#pragma unroll
            for (int e = 0; e < 2; ++e) {
                float P = 1.0f;
#pragma unroll
                for (int i = 0; i < 16; ++i) {
                    const float qv = e ? bfhi(qw[i]) : bflo(qw[i]), zv = e ? bfhi(fw[i]) : bflo(fw[i]);
                    float ff, kf;
                    if (type == 0) {
                        const float en = fast_exp2(-fabsf(zv) * LOG2E);
                        const float sp = fast_rcp(1.0f + en), sn = en * sp;
                        const float s1 = zv >= 0.f ? sp : sn, s0 = zv >= 0.f ? sn : sp;
                        kf = (1.0f - par[e]) * s0; ff = par[e] + (1.0f - par[e]) * s1; qo[e][i] = qv;
                    } else {
                        const float xg = zv + par[e];
                        const float lsg = fminf(xg, 0.f) - __logf(1.0f + fast_exp2(-fabsf(xg) * LOG2E));
                        ff = fast_exp2(lsg * (LOG2E / 16.0f)); kf = e ? bfhi(kw[i]) : bflo(kw[i]); qo[e][i] = qv * 0.08838834764831845f;
                    }
                    P *= ff;
                    qo[e][i] *= P; po[e][i] = kf * fminf(fast_rcp(P), 5.5e34f);
                }
                Dv[e] = P;
            }
#pragma unroll
            for (int i = 0; i < 16; ++i) { st_wt32(qp + (size_t)i * ld, cvt_pk_bf16(qo[0][i], qo[1][i])); st_wt32(kp + (size_t)i * ld, cvt_pk_bf16(po[0][i], po[1][i])); }
            float* dp = (type == 0 ? sb.DB : sb.DC) + (size_t)ck * nch + ch;
            st_wt32(dp, __float_as_uint(Dv[0])); st_wt32(dp + 1, __float_as_uint(Dv[1]));
        }
    }
}

__device__ __forceinline__ void phase_post(const bf16* UB, const bf16* UC, bf16* Y, const float* hg  , const float* gg  , int r_0, int r_end, int r_step, int lane) {
    float g1[16], g2[16];
#pragma unroll
    for (int e = 0; e < 16; ++e) { g1[e] = hg[16 * (lane & 7) + e]; g2[e] = gg[16 * (lane & 15) + e]; }
    for (int r = r_0; r < r_end; r += r_step) {
        {
            const bf16* po = UB + (size_t)r * 4096 + 2048 + 16 * lane; const bf16* pg = UB + (size_t)r * 4096 + 3072 + 16 * lane;
            float v[16], g[16]; unpack16(*(const u32x4*)po, *(const u32x4*)(po + 8), v); unpack16(*(const u32x4*)pg, *(const u32x4*)(pg + 8), g);
            float ss = 0.f;
#pragma unroll
            for (int e = 0; e < 16; ++e) { v[e] = v[e] * sigmoidf_(g[e]); ss += v[e] * v[e]; }
            ss += __shfl_xor(ss, 1); ss += __shfl_xor(ss, 2); ss += __shfl_xor(ss, 4);
            const float rstd = 1.0f / sqrtf(ss * (1.0f / 128.0f) + EPS);
#pragma unroll
            for (int e = 0; e < 16; ++e) v[e] = v[e] * rstd * g1[e];
            u32x4 oa, ob; pack16(v, oa, ob);
            bf16* py = Y + (size_t)r * 3072 + 1024 + 16 * lane; *(u32x4*)py = oa; *(u32x4*)(py + 8) = ob;
        }
        {
            const bf16* po = UC + (size_t)r * 3584 + 1024 + 16 * lane; const bf16* pg = UC + (size_t)r * 3584 + 2048 + 16 * lane;
            float v[16], g[16]; unpack16(*(const u32x4*)po, *(const u32x4*)(po + 8), v); unpack16(*(const u32x4*)pg, *(const u32x4*)(pg + 8), g);
            float ss = 0.f;
#pragma unroll
            for (int e = 0; e < 16; ++e) ss += v[e] * v[e];
            ss += __shfl_xor(ss, 1); ss += __shfl_xor(ss, 2); ss += __shfl_xor(ss, 4); ss += __shfl_xor(ss, 8);
            const float rstd = 1.0f / sqrtf(ss * (1.0f / 256.0f) + EPS);
#pragma unroll
            for (int e = 0; e < 16; ++e) v[e] = v[e] * rstd * g2[e] * siluf_(g[e]);
            u32x4 oa, ob; pack16(v, oa, ob);
            bf16* py = Y + (size_t)r * 3072 + 2048 + 16 * lane; *(u32x4*)py = oa; *(u32x4*)(py + 8) = ob;
        }
    }
}

constexpr int AT_KROW = 272, AT_VROW = 320, AT_KBUF = 64 * AT_KROW, AT_VBUF = 64 * AT_VROW;
constexpr int AT_K = 0, AT_V = 2 * AT_KBUF, AT_TBL = AT_V + 2 * AT_VBUF, AT_L = AT_TBL + 1024, AT_END = AT_L + 8 * 128;
static_assert(AT_END <= RING_BYTES && 4 * 16384 <= AT_TBL, "attention LDS");
__device__ __forceinline__ void attn_unit(LAS unsigned char* lds, const bf16* UA, bf16* Y, int bl, int h, int qb,
                                          const float* qkg, const float* rel_bias, const float* lamv, const float* dgain, float lam_init, int tid, int wave, int lane) {
    const int i = lane & 31, hi = lane >> 5, m = wave >> 2, wq = wave & 3;
    float gqm = fabsf(qkg[lane]), gkm = fabsf(qkg[64 + lane]), bm = lane < 32 ? fabsf(rel_bias[lane * 8 + h]) : 0.f;
    gqm = wave_max(gqm); gkm = wave_max(gkm); bm = wave_max(bm);
    const float Mb = (8.0f * gqm * gkm * 1.02f + bm) * LOG2E + 1.0f;
    const float s01 = wave_sum(lamv[lane] * lamv[64 + lane]), s23 = wave_sum(lamv[128 + lane] * lamv[192 + lane]);
    const float lam = __expf(s01) - __expf(s23) + lam_init;
    const float cb_far = rel_bias[15 * 8 + h] * LOG2E - Mb;
    LAS float* tbl = (LAS float*)(lds + AT_TBL);
    if (tid < 255) { const int rel = tid - 191, n = rel < 0 ? -rel : rel;
        int bk = n < 8 ? n : (8 + (31 - __clz(n * n)) - 6); if (bk > 15) bk = 15; if (rel > 0) bk += 16;
        tbl[tid] = rel_bias[bk * 8 + h] * LOG2E; }
    const int q0 = qb * 128 + wq * 32, qc = qb * 2 + (wq >> 1);
    bf16x8 qr[4];
    { const bf16* qp = UA + (size_t)(bl * SEQ + q0 + i) * 3072 + h * 128 + m * 64 + hi * 8;
#pragma unroll
      for (int d0 = 0; d0 < 4; ++d0) qr[d0] = *(const bf16x8*)(qp + d0 * 16); }
    f32x16 O[4];
#pragma unroll
    for (int e = 0; e < 4; ++e) O[e] = (f32x16){};
    float lsum = 0.f;
    const int NT = 2 * qb + 2;
    const bf16* ksrc = UA + (size_t)(bl * SEQ) * 3072 + 1024 + h * 128;
    const bf16* vsrc = UA + (size_t)(bl * SEQ) * 3072 + 2048 + h * 128;
    u32x4 rk[2], rv[2];
#define AT_LOAD(kt) do { _Pragma("unroll") for (int j = 0; j < 2; ++j) { const int c = tid + 512 * j; \
        rk[j] = *(const u32x4*)(ksrc + (size_t)((kt) * 64 + (c >> 4)) * 3072 + (c & 15) * 8); \
        rv[j] = *(const u32x4*)(vsrc + (size_t)((kt) * 64 + (c >> 4)) * 3072 + (c & 15) * 8); } } while (0)
#define AT_STORE(buf) do { _Pragma("unroll") for (int j = 0; j < 2; ++j) { const int c = tid + 512 * j; \
        *(LAS u32x4*)(lds + AT_K + (buf) * AT_KBUF + (c >> 4) * AT_KROW + (c & 15) * 16) = rk[j]; \
        *(LAS u32x4*)(lds + AT_V + (buf) * AT_VBUF + (c >> 4) * AT_VROW + (c & 15) * 16) = rv[j]; } } while (0)
    AT_LOAD(0); AT_STORE(0);
    __syncthreads();
    const int vtr_off = (8 * hi + ((lane & 15) >> 2)) * AT_VROW + (16 * ((lane >> 4) & 1) + 4 * (lane & 3)) * 2;
    const int pi = (i & 19) | ((i & 4) << 1) | ((i & 8) >> 1);
    for (int kt = 0; kt < NT; ++kt) {
        const int buf = kt & 1;
        if (kt + 1 < NT) AT_LOAD(kt + 1);
        if (kt <= qc) {
            const bool far_ = (qc - kt) >= 3;
            const LAS unsigned char* Kb = lds + AT_K + buf * AT_KBUF;
            const LAS unsigned char* Vb = lds + AT_V + buf * AT_VBUF;
            u32x4 P[4];
            const float cinit = far_ ? cb_far : -Mb;
            f32x16 S[2];
            bf16x8 kf[2][4];
#pragma unroll
            for (int blk = 0; blk < 2; ++blk)
#pragma unroll
                for (int d0 = 0; d0 < 4; ++d0) kf[blk][d0] = *(const LAS bf16x8*)(Kb + (32 * blk + pi) * AT_KROW + m * 128 + d0 * 32 + hi * 16);
#pragma unroll
            for (int blk = 0; blk < 2; ++blk)
#pragma unroll
                for (int r = 0; r < 16; ++r) S[blk][r] = cinit;
            __builtin_amdgcn_s_setprio(1);
#pragma unroll
            for (int d0 = 0; d0 < 4; ++d0)
#pragma unroll
                for (int blk = 0; blk < 2; ++blk) S[blk] = __builtin_amdgcn_mfma_f32_32x32x16_bf16(kf[blk][d0], qr[d0], S[blk], 0, 0, 0);
            __builtin_amdgcn_s_setprio(0);
            if (!far_) {
                const int rbase = 64 * kt - (q0 + i) + 191 + 8 * hi;
#pragma unroll
                for (int blk = 0; blk < 2; ++blk)
#pragma unroll
                    for (int r = 0; r < 16; ++r) S[blk][r] += tbl[rbase + 32 * blk + 16 * (r >> 3) + (r & 7)];
            }
#pragma unroll
            for (int blk = 0; blk < 2; ++blk) {
#pragma unroll
                for (int r = 0; r < 16; ++r) { S[blk][r] = fast_exp2(S[blk][r]); lsum += S[blk][r]; }
#pragma unroll
                for (int g = 0; g < 2; ++g) { u32x4 w; w.x = cvt_pk_bf16(S[blk][8 * g + 0], S[blk][8 * g + 1]); w.y = cvt_pk_bf16(S[blk][8 * g + 2], S[blk][8 * g + 3]);
                    w.z = cvt_pk_bf16(S[blk][8 * g + 4], S[blk][8 * g + 5]); w.w = cvt_pk_bf16(S[blk][8 * g + 6], S[blk][8 * g + 7]); P[2 * blk + g] = w; }
            }
#pragma unroll
            for (int ks = 0; ks < 4; ++ks) {
                bf16x8 vf[4];
#pragma unroll
                for (int eb = 0; eb < 4; ++eb) { const LAS unsigned char* vp = Vb + vtr_off + (16 * ks) * AT_VROW + eb * 64;
                    const s16x4 lo = __builtin_bit_cast(s16x4, __builtin_amdgcn_ds_read_tr16_b64_v4i16((LAS v4i16_t*)vp)), hi4 = __builtin_bit_cast(s16x4, __builtin_amdgcn_ds_read_tr16_b64_v4i16((LAS v4i16_t*)(vp + 4 * AT_VROW)));
                    vf[eb] = (bf16x8){lo[0], lo[1], lo[2], lo[3], hi4[0], hi4[1], hi4[2], hi4[3]}; }
                __builtin_amdgcn_s_setprio(1);
#pragma unroll
                for (int eb = 0; eb < 4; ++eb) O[eb] = __builtin_amdgcn_mfma_f32_32x32x16_bf16(__builtin_bit_cast(bf16x8, P[ks]), vf[eb], O[eb], 0, 0, 0);
                __builtin_amdgcn_s_setprio(0);
                __builtin_amdgcn_sched_barrier(0);
            }
        }
        if (kt + 1 < NT) AT_STORE(buf ^ 1);
        __syncthreads();
    }
#undef AT_LOAD
#undef AT_STORE
    lsum += __shfl_xor(lsum, 32);
    LAS float* L = (LAS float*)(lds + AT_L + wave * 128);
    if (hi == 0) L[i] = (m == 0 ? 1.0f : lam) / lsum;
    asm volatile("s_waitcnt lgkmcnt(0)" ::: "memory");
    LAS float* X = (LAS float*)(lds + wq * 16384);
#pragma unroll
    for (int r = 0; r < 16; ++r) { const float sc = L[(r & 3) + 8 * (r >> 2) + 4 * hi];
#pragma unroll
        for (int eb = 0; eb < 4; ++eb) O[eb][r] *= sc; }
    if (m == 1) {
#pragma unroll
        for (int eb = 0; eb < 4; ++eb)
#pragma unroll
            for (int r = 0; r < 16; ++r) X[(eb * 16 + r) * 64 + lane] = O[eb][r];
    }
    __syncthreads();
    if (m == 0) {
        float dg[4];
#pragma unroll
        for (int eb = 0; eb < 4; ++eb) dg[eb] = dgain[32 * eb + i] * (1.0f - lam_init);
#pragma unroll
        for (int r = 0; r < 16; ++r) {
            const int q = (r & 3) + 8 * (r >> 2) + 4 * hi;
            float o[4], ss = 0.f;
#pragma unroll
            for (int eb = 0; eb < 4; ++eb) { o[eb] = O[eb][r] - X[(eb * 16 + r) * 64 + lane]; ss += o[eb] * o[eb]; }
            ss += __shfl_xor(ss, 1); ss += __shfl_xor(ss, 2); ss += __shfl_xor(ss, 4); ss += __shfl_xor(ss, 8); ss += __shfl_xor(ss, 16);
            const float rstd = 1.0f / sqrtf(ss * (1.0f / 128.0f) + EPS);
            bf16* yp = Y + (size_t)(bl * SEQ + q0 + q) * 3072 + h * 128 + i;
#pragma unroll
            for (int eb = 0; eb < 4; ++eb) yp[32 * eb] = (bf16)(cvt_pk_bf16(o[eb] * rstd * dg[eb], 0.f) & 0xffffu);
        }
    }
    __syncthreads();
}

constexpr int S2_ROW = 272;
constexpr int S2_VROW = 288;
constexpr int S2_Q = 0, S2_KP = 64 * S2_ROW, S2_VT = 2 * 64 * S2_ROW, S2_D = S2_VT + 64 * S2_VROW, S2_O = S2_D + 2048, S2_END = S2_O + 64 * S2_ROW;
static_assert(S2_END <= RING_BYTES, "scan LDS");
__device__ __forceinline__ void scan_unit(LAS unsigned char* lds, bf16* UB, bf16* UC, const ScanBufs sb, unsigned* pre_cnt, unsigned pre_want, unsigned* scan_cnt, int type, int bl, int h, int j, int tid, int wave, int lane) {
    item_wait(pre_cnt, pre_want, tid);
    const bf16 *qsrc, *psrc; const float* dsrc; bf16* vdst; int ld, nch;
    if (type == 0) { ld = 4096; nch = 1024; qsrc = UB + h * 128; psrc = UB + 1024 + h * 128; dsrc = sb.DB + h * 128; vdst = UB + 2048 + h * 128; }
    else           { ld = 3584; nch = 512;  qsrc = UC + h * 128; psrc = UC + 512 + h * 128;  dsrc = sb.DC + h * 128; vdst = UC + 1024 + h * 256 + 128 * j; }
    const size_t rowb = (size_t)bl * SEQ;
    u32x4 rq[2], rp[2], rvt[2]; float rd;
#define S2_LOAD(tb) do { const size_t r0_ = rowb + (size_t)(tb) * 64, ck0_ = r0_ >> 4; \
        _Pragma("unroll") for (int k = 0; k < 2; ++k) { const int chn = tid + 512 * k; \
            rq[k] = *(const u32x4*)(qsrc + (r0_ + (chn >> 4)) * ld + (chn & 15) * 8); rp[k] = *(const u32x4*)(psrc + (r0_ + (chn >> 4)) * ld + (chn & 15) * 8); \
            rvt[k] = *(const u32x4*)(vdst + (r0_ + (chn >> 4)) * ld + (chn & 15) * 8); } \
        rd = dsrc[(ck0_ + (tid >> 7)) * nch + (tid & 127)]; } while (0)
    f32x4 S[8];
#pragma unroll
    for (int e = 0; e < 8; ++e) S[e] = (f32x4){0.f, 0.f, 0.f, 0.f};
    const int x = lane & 15, g = lane >> 4;
    S2_LOAD(0);
    for (int tb = 0; tb < SEQ / 64; ++tb) {
#pragma unroll
        for (int k = 0; k < 2; ++k) { const int chn = tid + 512 * k;
            *(LAS u32x4*)(lds + S2_Q + (chn >> 4) * S2_ROW + (chn & 15) * 16) = rq[k]; *(LAS u32x4*)(lds + S2_KP + (chn >> 4) * S2_ROW + (chn & 15) * 16) = rp[k];
            *(LAS u32x4*)(lds + S2_VT + (chn >> 4) * S2_VROW + (chn & 15) * 16) = rvt[k]; }
        *(LAS float*)(lds + S2_D + tid * 4) = rd;
        __syncthreads();
        if (tb + 1 < SEQ / 64) S2_LOAD(tb + 1);
        s16x4 sa[4], vf[4];
#pragma unroll
        for (int cc = 0; cc < 4; ++cc) {
            const LAS unsigned char* qrow = lds + S2_Q + (16 * cc + x) * S2_ROW;
            const LAS unsigned char* prow = lds + S2_KP + (16 * cc + x) * S2_ROW;
            f32x4 st = (f32x4){0.f, 0.f, 0.f, 0.f};
#pragma unroll
            for (int i = 0; i < 4; ++i) st = __builtin_amdgcn_mfma_f32_16x16x32_bf16(*(const LAS bf16x8*)(prow + 64 * i + 16 * g), *(const LAS bf16x8*)(qrow + 64 * i + 16 * g), st, 0, 0, 0);
#pragma unroll
            for (int r = 0; r < 4; ++r) if (4 * g + r > x) st[r] = 0.f;
            const u32x2 sw = (u32x2){cvt_pk_bf16(st[0], st[1]), cvt_pk_bf16(st[2], st[3])};
            sa[cc] = __builtin_bit_cast(s16x4, sw);
            vf[cc] = __builtin_bit_cast(s16x4, __builtin_amdgcn_ds_read_tr16_b64_v4i16((LAS v4i16_t*)(lds + S2_VT + (16 * cc + 4 * g + (x >> 2)) * S2_VROW + (16 * wave + 4 * (x & 3)) * 2)));
        }
        u32x2 qa[2][8];
#define S2_FETCH(cc, bufi) do { const LAS unsigned char* qrow_ = lds + S2_Q + (16 * (cc) + x) * S2_ROW; \
            _Pragma("unroll") for (int i = 0; i < 4; ++i) { qa[bufi][2 * i] = *(const LAS u32x2*)(qrow_ + 64 * i + 8 * g); qa[bufi][2 * i + 1] = *(const LAS u32x2*)(qrow_ + 64 * i + 32 + 8 * g); } } while (0)
        S2_FETCH(0, 0);
#pragma unroll
        for (int cc = 0; cc < 4; ++cc) {
            const int bi = cc & 1;
            f32x4 dv[8]; s16x4 ka[8];
#pragma unroll
            for (int rb = 0; rb < 8; ++rb) { dv[rb] = *(const LAS f32x4*)(lds + S2_D + (cc * 128 + 16 * rb + 4 * g) * 4); ka[rb] = __builtin_bit_cast(s16x4, __builtin_amdgcn_ds_read_tr16_b64_v4i16((LAS v4i16_t*)(lds + S2_KP + (16 * cc + 4 * g + (x >> 2)) * S2_ROW + (16 * rb + 4 * (x & 3)) * 2))); }
            if (cc < 3) { if (bi == 0) S2_FETCH(cc + 1, 1); else S2_FETCH(cc + 1, 0); }
            f32x4 o0 = (f32x4){0.f, 0.f, 0.f, 0.f}, o1 = (f32x4){0.f, 0.f, 0.f, 0.f};
#pragma unroll
            for (int i = 0; i < 4; ++i) {
                const u32x4 sfw = (u32x4){cvt_pk_bf16(S[2 * i][0], S[2 * i][1]), cvt_pk_bf16(S[2 * i][2], S[2 * i][3]), cvt_pk_bf16(S[2 * i + 1][0], S[2 * i + 1][1]), cvt_pk_bf16(S[2 * i + 1][2], S[2 * i + 1][3])};
                const u32x4 qaw = (u32x4){qa[bi][2 * i].x, qa[bi][2 * i].y, qa[bi][2 * i + 1].x, qa[bi][2 * i + 1].y};
                if (i & 1) o1 = __builtin_amdgcn_mfma_f32_16x16x32_bf16(__builtin_bit_cast(bf16x8, qaw), __builtin_bit_cast(bf16x8, sfw), o1, 0, 0, 0);
                else       o0 = __builtin_amdgcn_mfma_f32_16x16x32_bf16(__builtin_bit_cast(bf16x8, qaw), __builtin_bit_cast(bf16x8, sfw), o0, 0, 0, 0);
            }
#pragma unroll
            for (int rb = 0; rb < 8; ++rb) S[rb] = __builtin_amdgcn_mfma_f32_16x16x16bf16_1k(ka[rb], vf[cc], S[rb], 0, 0, 0) * dv[rb];
            o0 = __builtin_amdgcn_mfma_f32_16x16x16bf16_1k(sa[cc], vf[cc], o0, 0, 0, 0);
            o0 = o0 + o1;
#pragma unroll
            for (int r = 0; r < 4; ++r) *(LAS unsigned short*)(lds + S2_O + (16 * cc + 4 * g + r) * S2_ROW + (16 * wave + x) * 2) = (unsigned short)(cvt_pk_bf16(o0[r], 0.f) & 0xffffu);
        }
#undef S2_FETCH
        __syncthreads();
#pragma unroll
        for (int k = 0; k < 2; ++k) { const int ch = tid + 512 * k, row = ch >> 4, c16 = ch & 15;
            st_wt128(vdst + (rowb + (size_t)tb * 64 + row) * ld + c16 * 8, *(const LAS u32x4*)(lds + S2_O + row * S2_ROW + c16 * 16)); }
    }
#undef S2_LOAD
    item_publish(scan_cnt, tid);
}

#ifndef PROBE
#define PROBE 0
#endif
#ifndef MK_PER_PHASE
#define MK_PER_PHASE 0
#endif
constexpr int NPH_LAYER = 14, NPH = 1 + 2 * NPH_LAYER + 1;
struct Args { const float* in[20]; float* out; unsigned char* ws; int ph_lo, ph_hi, li, pad; };

__global__ void __launch_bounds__(512, 2) fwd(Args a) {
    extern __shared__ __attribute__((aligned(16))) unsigned char lds_[];
    LAS unsigned char* lds = (LAS unsigned char*)lds_;
    const int tid = threadIdx.x, lane = tid & 63, wave = __builtin_amdgcn_readfirstlane(tid >> 6);
    const int G = (int)gridDim.x, blk = (int)blockIdx.x;
    for (int u = tid; u < (LDS_BYTES - LDSCTL_OFF) / 4; u += 512) ((LAS unsigned*)(lds + LDSCTL_OFF))[u] = 0u;
    __syncthreads();
    volatile LAS unsigned* MISC = (volatile LAS unsigned*)(lds + MISC_OFF);
    unsigned char* ws = a.ws;
    unsigned* ctl = (unsigned*)(ws + WS_CTL);
    const int lo = a.ph_lo, hi = a.ph_hi;
    XcdBarrier bar; bar.bar = ctl + CW_BAR; bar.x = 0; bar.st = nullptr;
    if (hi - lo > 1) bar = xcd_barrier_post(ctl + CW_BAR + a.li * XCD_BAR_WORDS, MISC + 8);
    In in;
    in.x = a.in[0]; in.c = a.in[1]; in.w_ada = a.in[2]; in.b_ada = a.in[3]; in.norm_gains = a.in[4]; in.w_gate = a.in[5]; in.w_up = a.in[6]; in.w_down = a.in[7]; in.w_in = a.in[8];
    in.qk_gains = a.in[9]; in.diff_lambda = a.in[10]; in.diff_out_gain = a.in[11]; in.rel_bias = a.in[12]; in.lb_logits = a.in[13]; in.hgrn_gain = a.in[14]; in.gla_w_up = a.in[15];
    in.gla_b = a.in[16]; in.gla_gain = a.in[17]; in.w_branch = a.in[18]; in.w_out = a.in[19];
    float* out = a.out;
    float* mod = (float*)(ws + WS_MOD);
    bf16* H = (bf16*)(ws + WS_H); bf16* ACT = (bf16*)(ws + WS_ACT);
    bf16* UA = (bf16*)(ws + WS_UA); bf16* UB = (bf16*)(ws + WS_UB); bf16* UC = (bf16*)(ws + WS_UC); bf16* UG = (bf16*)(ws + WS_UG); bf16* Y = (bf16*)(ws + WS_Y); _Float16* XH = (_Float16*)(ws + WS_XH);
    const ScanBufs sb{(float*)(ws + WS_DB), (float*)(ws + WS_DC)};
    int ph = 0;
#define IN_(k) (lo <= (k) && (k) < hi)
#define SEAM() do { if (IN_(ph) && IN_(ph + 1)) xcd_barrier(bar); ++ph; asm volatile("" : "+v"(tid_)); lane_ = tid_ & 63; wave_ = __builtin_amdgcn_readfirstlane(tid_ >> 6); } while (0)
    int tid_ = tid, lane_ = lane, wave_ = wave;
#define PBAR() do { if (hi - lo > 1) xcd_barrier(bar); asm volatile("" : "+v"(tid_)); lane_ = tid_ & 63; wave_ = __builtin_amdgcn_readfirstlane(tid_ >> 6); } while (0)

    for (int rep = 0; rep < (PROBE == 7 ? 2 : 1); ++rep) { if (rep) PBAR();
    if (IN_(ph)) phase_prologue(in, ws, lds, tid_, wave_, lane_); }
    SEAM();
    for (int l = 0; l < 2; ++l) {
        const float* modl = mod + (size_t)l * 8 * NMOD;
        const float* gains = in.norm_gains + (size_t)l * 4 * D;
        const float lam_init = l == 0 ? 0.2f : 0.35550906759f;
        if (IN_(ph)) {
            if (l == 0) phase_mod<0, true>(in.x, nullptr, nullptr, H, nullptr, gains, modl, modl + D, wave_, lane_);
            else phase_mod<1, false>(nullptr, XH, nullptr, H, in.norm_gains + (size_t)(l - 1) * 4 * D + 3 * D, gains, modl, modl + D, wave_, lane_);
        }
        SEAM();
        for (int rep = 0; rep < (PROBE == 1 ? 2 : 1); ++rep) { if (rep) PBAR();
        if (IN_(ph)) { pg8::Gemm g{H, (const bf16*)(ws + WS_WGU + (size_t)(l * 2 + 0) * SZ_WGU), D, D, D, 0, 0}; pg8::StaticOrder S; S.init(M, 2 * FF, G, blk, 1);
            pg8::EpiSwiglu E{ACT}; pg8::gemm_phase(lds, g, S, E, tid_); } }
        SEAM();
        if (IN_(ph)) { pg8::Gemm g{ACT, (const bf16*)(ws + WS_WD + (size_t)(l * 2 + 0) * SZ_WD), FF, FF, FF, 0, 0}; pg8::StaticOrder S; S.init(M, D, G, blk, 1);
            pg8::EpiResid E{l == 0 ? in.x : nullptr, XH, modl + 2 * D, 0.5f, 0}; pg8::gemm_phase(lds, g, S, E, tid_); }
        SEAM();
        for (int rep = 0; rep < (PROBE == 4 ? 2 : 1); ++rep)
        if (IN_(ph)) phase_mod<0, false>(nullptr, XH, nullptr, H, nullptr, gains + D, modl + 3 * D, modl + 4 * D, wave_, lane_);
        SEAM();
        for (int half = 0; half < 2; ++half) {
            bf16* Hh = H + (size_t)half * MH * D;
            if (IN_(ph)) { pg8::Gemm g{Hh, (const bf16*)(ws + WS_WIN + (size_t)l * SZ_WIN), D, D, D, 0, 0}; pg8::StaticOrder S; S.init(MH, NWIN, G, blk, 1);
                pg8::EpiWin E{UA, UB, UC, UG, in.qk_gains + l * 128}; pg8::gemm_phase(lds, g, S, E, tid_);
                if (PROBE == 2) { PBAR(); pg8::gemm_phase(lds, g, S, E, tid_); } }
            SEAM();
            if (IN_(ph)) {
                constexpr int Q_PRE = 768, Q_SCAN = Q_PRE + 64, Q_ATT = Q_SCAN + 1024, Q_POST = Q_ATT + 256;
                unsigned* qh = ctl + CW_QUEUE + 64 * (l * 2 + half);
                unsigned* pre_cnt = ctl + CW_QUEUE + 64 * (8 + l * 2 + half); unsigned* scan_cnt = ctl + CW_QUEUE + 64 * (16 + l * 2 + half);
                for (int seq = 0;; ++seq) {
                    if (seq >= 3) { if (tid_ == 0) MISC[16] = Q_PRE + __hip_atomic_fetch_add(qh, 1u, __ATOMIC_RELAXED, __HIP_MEMORY_SCOPE_AGENT); }
                    else if (tid_ == 0) MISC[16] = (unsigned)(blk + 256 * seq);
                    __syncthreads();
                    const int item = (int)MISC[16];
                    __syncthreads();
                    if (item >= Q_POST) break;
                    int t2 = tid_; asm volatile("" : "+v"(t2)); const int l2 = t2 & 63, w2 = __builtin_amdgcn_readfirstlane(t2 >> 6);
                    if (item < Q_PRE) { phase_pre(UB, UC, sb, l, in.lb_logits, in.gla_b + l * 512, item * 16 + w2, item * 16 + 16, 8, l2); item_publish(pre_cnt, t2); }
                    else if (item < Q_PRE + 32) { const int id = item - Q_PRE; scan_unit(lds, UB, UC, sb, pre_cnt, Q_PRE, scan_cnt, 0, id >> 3, id & 7, 0, t2, w2, l2); }
                    else if (item < Q_SCAN) { const int id = item - Q_PRE - 32; scan_unit(lds, UB, UC, sb, pre_cnt, Q_PRE, scan_cnt, 1, id >> 3, (id >> 1) & 3, id & 1, t2, w2, l2); }
                    else if (item < Q_ATT) { const int id = item - Q_SCAN, qb = 31 - ((id & 255) >> 3), bh = (id >> 8) * 8 + (id & 7);
                        attn_unit(lds, UA, Y, bh >> 3, bh & 7, qb, in.qk_gains + l * 128, in.rel_bias, in.diff_lambda + l * 256, in.diff_out_gain + l * 128, lam_init, t2, w2, l2); }
                    else { const int id = item - Q_ATT; item_wait(scan_cnt, 64u, t2); phase_post(UB, UC, Y, in.hgrn_gain + l * 128, in.gla_gain + l * 256, id * 64 + w2, id * 64 + 64, 8, l2); }
                }
            }
            SEAM();
            if (IN_(ph)) { pg8::Gemm g{Y, (const bf16*)(ws + WS_WB + (size_t)l * SZ_WB), 3072, MIXW, MIXW, (size_t)MIXW, (size_t)D * MIXW}; pg8::StaticOrder S; S.init(MH, D, G, blk, 3);
                pg8::EpiMerge E{UG, Hh}; pg8::gemm_phase(lds, g, S, E, tid_);
                if (PROBE == 6) { PBAR(); pg8::gemm_phase(lds, g, S, E, tid_); } }
            SEAM();
        }
        if (IN_(ph)) { pg8::Gemm g{H, (const bf16*)(ws + WS_WO + (size_t)l * SZ_WO), D, D, D, 0, 0}; pg8::StaticOrder S; S.init(M, D, G, blk, 1);
            pg8::EpiResid E{nullptr, XH, modl + 5 * D, 1.0f, 0}; pg8::gemm_phase(lds, g, S, E, tid_); }
        SEAM();
        for (int rep = 0; rep < (PROBE == 4 ? 2 : 1); ++rep)
        if (IN_(ph)) phase_mod<0, false>(nullptr, XH, nullptr, H, nullptr, gains + 2 * D, modl + 6 * D, modl + 7 * D, wave_, lane_);
        SEAM();
        for (int rep = 0; rep < (PROBE == 1 ? 2 : 1); ++rep) { if (rep) PBAR();
        if (IN_(ph)) { pg8::Gemm g{H, (const bf16*)(ws + WS_WGU + (size_t)(l * 2 + 1) * SZ_WGU), D, D, D, 0, 0}; pg8::StaticOrder S; S.init(M, 2 * FF, G, blk, 1);
            pg8::EpiSwiglu E{ACT}; pg8::gemm_phase(lds, g, S, E, tid_); } }
        SEAM();
        if (IN_(ph)) { pg8::Gemm g{ACT, (const bf16*)(ws + WS_WD + (size_t)(l * 2 + 1) * SZ_WD), FF, FF, FF, 0, 0}; pg8::StaticOrder S; S.init(M, D, G, blk, 1);
            pg8::EpiResid E{nullptr, XH, modl + 8 * D, 0.5f, 0}; pg8::gemm_phase(lds, g, S, E, tid_); }
        SEAM();
    }
    if (IN_(ph)) phase_mod<2, false>(nullptr, XH, out, nullptr, in.norm_gains + (size_t)1 * 4 * D + 3 * D, nullptr, nullptr, nullptr, wave_, lane_);
#undef IN_
#undef SEAM
#undef PBAR
}

extern "C" void kernel_launch(void* const* d_in, const int* in_sizes, int n_in, void* d_out, int out_size, void* d_ws, size_t ws_size, hipStream_t stream) {
    static int ready = 0;
    if (ready == 0) {
        if (n_in != 20 || out_size != M * D || ws_size < WS_END) { fprintf(stderr, "kernel_launch: unexpected shapes (n_in %d, out %d, ws %zu < %zu)\n", n_in, out_size, ws_size, (size_t)WS_END); ready = -1; return; }
        if (hipFuncSetAttribute((const void*)fwd, hipFuncAttributeMaxDynamicSharedMemorySize, LDS_BYTES) != hipSuccess) { fprintf(stderr, "kernel_launch: hipFuncSetAttribute failed\n"); ready = -1; return; }
        (void)hipGetLastError();
        ready = 1;
    }
    if (ready < 0) return;
    if (hipMemsetAsync((char*)d_ws + WS_CTL, 0, CTL_ZERO_BYTES, stream) != hipSuccess) return;
    Args a{};
    for (int i = 0; i < 20; ++i) a.in[i] = (const float*)d_in[i];
    a.out = (float*)d_out; a.ws = (unsigned char*)d_ws; a.li = 0; a.pad = 0;
#if MK_PER_PHASE
    for (int p = 0; p < NPH; ++p) { a.ph_lo = p; a.ph_hi = p + 1; hipLaunchKernelGGL(fwd, dim3(256), dim3(512), LDS_BYTES, stream, a); }
#else
    a.ph_lo = 0; a.ph_hi = NPH;
    hipLaunchKernelGGL(fwd, dim3(256), dim3(512), LDS_BYTES, stream, a);
#endif
}
```

```cpp
#include <hip/hip_runtime.h>
#include <cstdio>
#include <cstdint>

#define GAS __attribute__((address_space(1)))
#define LAS __attribute__((address_space(3)))
typedef unsigned short bf16;
typedef short bf16x8 __attribute__((ext_vector_type(8)));
typedef float f32x4 __attribute__((ext_vector_type(4)));
typedef float f32x16 __attribute__((ext_vector_type(16)));
typedef unsigned u32x4 __attribute__((ext_vector_type(4)));
typedef unsigned u32x2 __attribute__((ext_vector_type(2)));
typedef short s16x4 __attribute__((ext_vector_type(4)));
typedef short v4i16_t __attribute__((ext_vector_type(4)));
typedef _Float16 h16x8 __attribute__((ext_vector_type(8)));

constexpr int D = 2048, NBATCH = 8, SEQ = 4096, M = NBATCH * SEQ, FF = 5632, NIN = 16400, NWIN = 16896, MIXW = 1024;
constexpr int MH = M / 2;
constexpr int NMOD = 9 * D;
constexpr float EPS = 1e-6f;
constexpr float LOG2E = 1.4426950408889634f;

constexpr size_t MiB = 1u << 20;
constexpr size_t WS_CTL = 0, CTL_ZERO_BYTES = 1 * MiB;
constexpr size_t WS_MOD = 1 * MiB;
constexpr size_t SZ_WGU = (size_t)2 * FF * D * 2, SZ_WD = (size_t)D * FF * 2, SZ_WIN = (size_t)NWIN * D * 2, SZ_WB = (size_t)3 * D * MIXW * 2, SZ_WO = (size_t)D * D * 2;
constexpr size_t WS_WGU = 4 * MiB;
constexpr size_t WS_WD = WS_WGU + 4 * SZ_WGU;
constexpr size_t WS_WIN = WS_WD + 4 * SZ_WD;
constexpr size_t WS_WB = WS_WIN + 2 * SZ_WIN;
constexpr size_t WS_WO = WS_WB + 2 * SZ_WB;
constexpr size_t WS_H = WS_WO + 2 * SZ_WO;
constexpr size_t WS_AR = WS_H + (size_t)M * D * 2;
constexpr size_t SZ_UA = (size_t)MH * 3072 * 2, SZ_UB = (size_t)MH * 4096 * 2, SZ_UC = (size_t)MH * 3584 * 2, SZ_UG = (size_t)MH * 6144 * 2, SZ_Y = (size_t)MH * 3072 * 2;
constexpr size_t WS_UA = WS_AR, WS_UB = WS_UA + SZ_UA, WS_UC = WS_UB + SZ_UB, WS_UG = WS_UC + SZ_UC, WS_Y = WS_UG + SZ_UG,
    WS_DB = WS_Y + SZ_Y, WS_DC = WS_DB + (size_t)(MH / 16) * 1024 * 4, WS_XH = WS_DC + (size_t)(MH / 16) * 512 * 4, WS_END = WS_XH + (size_t)M * D * 2;
constexpr size_t WS_ACT = WS_AR;
static_assert(WS_ACT + (size_t)M * FF * 2 <= WS_END, "act fits in the arena");
static_assert(WS_END <= (size_t)1400 * MiB, "workspace budget");
constexpr int CW_BAR = 4096;
constexpr int CW_QUEUE = 16384;

constexpr int RING_BYTES = 139264;
constexpr int LDSCTL_OFF = RING_BYTES, MISC_OFF = LDSCTL_OFF + 320;
constexpr int LDS_BYTES = 147456;

__device__ __forceinline__ unsigned cvt_pk_bf16(float lo, float hi) { unsigned r; asm volatile("v_cvt_pk_bf16_f32 %0, %1, %2" : "=v"(r) : "v"(lo), "v"(hi)); return r; }
__device__ __forceinline__ float bflo(unsigned w) { return __uint_as_float(w << 16); }
__device__ __forceinline__ float bfhi(unsigned w) { return __uint_as_float(w & 0xffff0000u); }
__device__ __forceinline__ void h8_to_f(const h16x8 v, f32x4& a, f32x4& b) { a = (f32x4){(float)v[0], (float)v[1], (float)v[2], (float)v[3]}; b = (f32x4){(float)v[4], (float)v[5], (float)v[6], (float)v[7]}; }
__device__ __forceinline__ h16x8 f_to_h8(const f32x4 a, const f32x4 b) { return (h16x8){(_Float16)a[0], (_Float16)a[1], (_Float16)a[2], (_Float16)a[3], (_Float16)b[0], (_Float16)b[1], (_Float16)b[2], (_Float16)b[3]}; }
__device__ __forceinline__ float wave_sum(float v) {
#pragma unroll
    for (int o = 1; o < 64; o <<= 1) v += __shfl_xor(v, o);
    return v;
}
__device__ __forceinline__ float wave_max(float v) {
#pragma unroll
    for (int o = 1; o < 64; o <<= 1) v = fmaxf(v, __shfl_xor(v, o));
    return v;
}
__device__ __forceinline__ float fast_rcp(float x) { return __builtin_amdgcn_rcpf(x); }
__device__ __forceinline__ float fast_exp2(float x) { return __builtin_amdgcn_exp2f(x); }
__device__ __forceinline__ float sigmoidf_(float x) { return fast_rcp(1.0f + fast_exp2(-x * LOG2E)); }
__device__ __forceinline__ float siluf_(float x) { return x * sigmoidf_(x); }

namespace pg8 {
constexpr int BM = 256, BK = 64, HALF = 128, HTB = HALF * BK * 2, STAGE_BYTES = 8 * HTB, NXCD = 8, WGM = 8;
__host__ __device__ __forceinline__ int lds_byte(int r, int c) { const int st = (r >> 4) * 2 + (c >> 5), rr = r & 15, cc = c & 31, ob = rr * 64 + cc * 2; return st * 1024 + (ob ^ (((ob >> 9) & 1) << 5)); }
__host__ __device__ __forceinline__ void stage_rc(int b, int& R, int& C) { const int st = b / 1024, sb = b % 1024, swz = sb ^ (((sb >> 9) & 1) << 5); R = (st >> 1) * 16 + swz / 64; C = (st & 1) * 32 + (swz % 64) / 2; }
__host__ __device__ __forceinline__ int perm32(int rho) { const int n = rho >> 4, i = rho & 15; return 8 * (i >> 2) + 4 * n + (i & 3); }

struct Unit { int pm, pn, n; };
struct Gemm { const bf16* A; const bf16* Bt; int lda, ldb, K; size_t a_nstride, b_nstride; };

struct StaticOrder {
    int nM, nN, nwg, G, c, NS;
    __device__ void init(int Mrows, int N, int G_, int c_, int NS_) { nM = Mrows / BM; nN = N / BM; nwg = nM * nN; G = G_; c = c_; NS = NS_; }
    __device__ bool next(int ii, Unit& u) const {
        const int i = ii / NS; u.n = ii - i * NS;
        const long L = (long)i * G + c; if (L >= nwg) return false;
        int wgid = (int)L; { const int q = nwg / NXCD, r = nwg % NXCD, xcd = wgid % NXCD, off = wgid / NXCD; wgid = (xcd < r ? xcd * (q + 1) : r * (q + 1) + (xcd - r) * q) + off; }
        const int nig = WGM * nN, gid = wgid / nig, fm = gid * WGM, gsz = (nM - fm) < WGM ? (nM - fm) : WGM;
        u.pm = fm + ((wgid % nig) % gsz); u.pn = (wgid % nig) / gsz; return true;
    }
};

template <class Epi>
__device__ __forceinline__ void gemm_phase(LAS unsigned char* lds, const Gemm g, const StaticOrder& S, const Epi& E, const int tid) {
    const int wid = __builtin_amdgcn_readfirstlane(tid >> 6), lane = tid & 63, wr = wid >> 2, wc = wid & 3, fr = lane & 15, fq = lane >> 4;
    const int K = g.K, nt = K / BK;
    unsigned voffA[2], voffB[2];
#pragma unroll
    for (int i = 0; i < 2; ++i) { int R, C; stage_rc(tid * 16 + i * 8192, R, C); const int Rb = Epi::PERM ? ((R & ~31) + perm32(R & 31)) : R;
        voffA[i] = (unsigned)(R * g.lda + C) * 2u; voffB[i] = (unsigned)(Rb * g.ldb + C) * 2u; }
    const size_t kstep = (size_t)(BK * 2);
    const size_t hsA = (size_t)HALF * g.lda * 2, hsB = (size_t)HALF * g.ldb * 2;
    const size_t tsA = 2 * hsA, tsB = 2 * hsB;
    const unsigned ldsw = (unsigned)wid * 1024u;
    const int aoff = lds_byte(wr * 64 + fr, fq * 8), boff = lds_byte(wc * 32 + fr, fq * 8);
#define PG8_SA(b, h) (((b) * 2 + (h)) * HTB)
#define PG8_SB(b, h) ((4 + (b) * 2 + (h)) * HTB)
#define PG8_STAGE(bufoff, gbase, voff) do { _Pragma("unroll") for (int _i = 0; _i < 2; ++_i) \
        __builtin_amdgcn_global_load_lds((const unsigned*)((const char*)(gbase) + (voff)[_i]), (LAS unsigned*)(lds + (bufoff) + ldsw + _i * 8192), 16, 0, 0); } while (0)
#define PG8_LDA(dst, b, h) do { _Pragma("unroll") for (int m = 0; m < 4; ++m) _Pragma("unroll") for (int k = 0; k < 2; ++k) dst[m][k] = *(const LAS bf16x8*)(lds + PG8_SA(b, h) + aoff + m * 2048 + k * 1024); } while (0)
#define PG8_LDB(dst, b, h) do { _Pragma("unroll") for (int n = 0; n < 2; ++n) _Pragma("unroll") for (int k = 0; k < 2; ++k) dst[n][k] = *(const LAS bf16x8*)(lds + PG8_SB(b, h) + boff + n * 2048 + k * 1024); } while (0)
#define PG8_MMA(ai, bj, At, Bt) do { __builtin_amdgcn_s_setprio(1); _Pragma("unroll") for (int m = 0; m < 4; ++m) _Pragma("unroll") for (int n = 0; n < 2; ++n) _Pragma("unroll") for (int k = 0; k < 2; ++k) \
        acc[ai][bj][m][n] = __builtin_amdgcn_mfma_f32_16x16x32_bf16(Bt[n][k], At[m][k], acc[ai][bj][m][n], 0, 0, 0); __builtin_amdgcn_s_setprio(0); } while (0)
#define PG8_WAIT_V(n) asm volatile("s_waitcnt vmcnt(" #n ")" ::: "memory")
#define PG8_WAIT_L(n) asm volatile("s_waitcnt lgkmcnt(" #n ")" ::: "memory")
#define PG8_BAR __builtin_amdgcn_s_barrier()
#define PG8_SCHED __builtin_amdgcn_sched_barrier(0)
#define PG8_APTR(u) ((const char*)(g.A + (size_t)(u).n * g.a_nstride) + (size_t)(u).pm * tsA)
#define PG8_BPTR(u) ((const char*)(g.Bt + (size_t)(u).n * g.b_nstride) + (size_t)(u).pn * tsB)
    Unit cur, nxt; int ui = 0;
    if (!S.next(0, cur)) return;
    f32x4 acc[2][2][4][2];
#pragma unroll
    for (int a = 0; a < 2; ++a)
#pragma unroll
        for (int b = 0; b < 2; ++b)
#pragma unroll
            for (int m = 0; m < 4; ++m)
#pragma unroll
                for (int n = 0; n < 2; ++n) acc[a][b][m][n] = (f32x4){0.f, 0.f, 0.f, 0.f};
    bf16x8 At[4][2], B0[2][2], B1[2][2];
    const char* cA = PG8_APTR(cur); const char* cB = PG8_BPTR(cur);
    PG8_STAGE(PG8_SB(0, 0), cB, voffB); PG8_STAGE(PG8_SB(0, 1), cB + hsB, voffB); PG8_STAGE(PG8_SA(0, 0), cA, voffA); PG8_STAGE(PG8_SA(0, 1), cA + hsA, voffA);
    if (wr == 1) PG8_BAR;
    PG8_WAIT_V(2); PG8_BAR;
    PG8_STAGE(PG8_SB(1, 0), cB + kstep, voffB); PG8_STAGE(PG8_SA(1, 0), cA + kstep, voffA); PG8_STAGE(PG8_SB(1, 1), cB + hsB + kstep, voffB);
    PG8_WAIT_V(6); PG8_BAR;
    for (;;) {
        const bool has_next = S.next(ui + 1, nxt);
        const char* nA = has_next ? PG8_APTR(nxt) : cA; const char* nB = has_next ? PG8_BPTR(nxt) : cB;
        for (int t = 0; t < nt; t += 2) {
            const bool last = (t == nt - 2);
            const char* a1 = cA + (size_t)(t + 1) * kstep;
            const char* a2 = last ? nA : cA + (size_t)(t + 2) * kstep; const char* b2 = last ? nB : cB + (size_t)(t + 2) * kstep;
            const char* a3 = a2 + kstep; const char* b3 = b2 + kstep;
            PG8_LDB(B0, 0, 0); PG8_LDB(B1, 0, 1); PG8_SCHED; PG8_LDA(At, 0, 0); PG8_STAGE(PG8_SA(1, 1), a1 + hsA, voffA);
            PG8_WAIT_V(8); PG8_WAIT_L(0); PG8_BAR; PG8_MMA(0, 0, At, B0); PG8_MMA(0, 1, At, B1); PG8_BAR; PG8_SCHED;
            PG8_LDA(At, 0, 1); PG8_STAGE(PG8_SB(0, 0), b2, voffB); PG8_STAGE(PG8_SB(0, 1), b2 + hsB, voffB); PG8_STAGE(PG8_SA(0, 0), a2, voffA);
            PG8_WAIT_V(8); PG8_WAIT_L(0); PG8_BAR; PG8_MMA(1, 0, At, B0); PG8_MMA(1, 1, At, B1); PG8_BAR; PG8_SCHED;
            PG8_LDB(B0, 1, 0); PG8_LDB(B1, 1, 1); PG8_SCHED; PG8_LDA(At, 1, 0); PG8_STAGE(PG8_SA(0, 1), a2 + hsA, voffA);
            PG8_WAIT_V(8); PG8_WAIT_L(0); PG8_BAR; PG8_MMA(0, 0, At, B0); PG8_MMA(0, 1, At, B1); PG8_BAR; PG8_SCHED;
            PG8_LDA(At, 1, 1); PG8_STAGE(PG8_SB(1, 0), b3, voffB); PG8_STAGE(PG8_SB(1, 1), b3 + hsB, voffB); PG8_STAGE(PG8_SA(1, 0), a3, voffA);
            PG8_WAIT_V(8); PG8_WAIT_L(0); PG8_BAR; PG8_MMA(1, 0, At, B0); PG8_MMA(1, 1, At, B1); PG8_BAR; PG8_SCHED;
        }
        if (wr == 0) PG8_BAR;
        E(acc, cur, wr, wc, fr, fq);
        if (!has_next) break;
        if (!(Epi::CHAIN && cur.n + 1 < S.NS)) {
#pragma unroll
        for (int a = 0; a < 2; ++a)
#pragma unroll
            for (int b = 0; b < 2; ++b)
#pragma unroll
                for (int m = 0; m < 4; ++m)
#pragma unroll
                    for (int n = 0; n < 2; ++n) acc[a][b][m][n] = (f32x4){0.f, 0.f, 0.f, 0.f};
        }
        cur = nxt; cA = nA; cB = nB; ++ui;
        if (wr == 1) PG8_BAR;
    }
    PG8_WAIT_V(0);
    PG8_BAR;
#undef PG8_SA
#undef PG8_SB
#undef PG8_STAGE
#undef PG8_LDA
#undef PG8_LDB
#undef PG8_MMA
#undef PG8_WAIT_V
#undef PG8_WAIT_L
#undef PG8_BAR
#undef PG8_SCHED
#undef PG8_APTR
#undef PG8_BPTR
}

struct EpiSwiglu {
    static constexpr bool PERM = true, CHAIN = false;
    bf16* O;
    __device__ __forceinline__ void operator()(f32x4 (&acc)[2][2][4][2], const Unit& u, int wr, int wc, int fr, int fq) const {
        const int row0 = u.pm * BM + wr * 64 + fr, col0 = u.pn * 128 + wc * 32 + 8 * fq;
#pragma unroll
        for (int ai = 0; ai < 2; ++ai)
#pragma unroll
            for (int m = 0; m < 4; ++m) {
                bf16* rowp = O + (size_t)(row0 + ai * HALF + m * 16) * FF + col0;
                const f32x4 g0 = acc[ai][0][m][0], g1 = acc[ai][0][m][1], u0 = acc[ai][1][m][0], u1 = acc[ai][1][m][1];
                u32x4 w;
                w.x = cvt_pk_bf16(siluf_(g0[0]) * u0[0], siluf_(g0[1]) * u0[1]); w.y = cvt_pk_bf16(siluf_(g0[2]) * u0[2], siluf_(g0[3]) * u0[3]);
                w.z = cvt_pk_bf16(siluf_(g1[0]) * u1[0], siluf_(g1[1]) * u1[1]); w.w = cvt_pk_bf16(siluf_(g1[2]) * u1[2], siluf_(g1[3]) * u1[3]);
                __builtin_nontemporal_store(w, (u32x4*)rowp);
            }
    }
};
struct EpiResid {
    static constexpr bool PERM = true, CHAIN = false;
    const float* base32; _Float16* xh; const float* gate; float coef; int row_off;
    __device__ __forceinline__ void operator()(f32x4 (&acc)[2][2][4][2], const Unit& u, int wr, int wc, int fr, int fq) const {
        const int lrow0 = row_off + u.pm * BM + wr * 64 + fr, col0 = u.pn * BM + wc * 32 + 8 * fq;
        const int b = (row_off + u.pm * BM) >> 12;
        const float* gp = gate + (size_t)b * NMOD + col0;
        f32x4 gv[2][2];
#pragma unroll
        for (int bj = 0; bj < 2; ++bj)
#pragma unroll
            for (int n = 0; n < 2; ++n) gv[bj][n] = *(const f32x4*)(gp + bj * HALF + 4 * n) * coef;
        _Float16* xp = xh + (size_t)lrow0 * D + col0;
        if (base32) {
            const float* bp = base32 + (size_t)lrow0 * D + col0;
#pragma unroll
            for (int am = 0; am < 8; am += 2) {
                f32x4 xb[2][2][2];
#pragma unroll
                for (int mm = 0; mm < 2; ++mm)
#pragma unroll
                    for (int bj = 0; bj < 2; ++bj) { const int ai = (am + mm) >> 2, m = (am + mm) & 3; const float* p = bp + (size_t)(ai * HALF + m * 16) * D + bj * HALF; xb[mm][bj][0] = *(const f32x4*)p; xb[mm][bj][1] = *(const f32x4*)(p + 4); }
#pragma unroll
                for (int mm = 0; mm < 2; ++mm)
#pragma unroll
                    for (int bj = 0; bj < 2; ++bj) { const int ai = (am + mm) >> 2, m = (am + mm) & 3;
                        *(h16x8*)(xp + (size_t)(ai * HALF + m * 16) * D + bj * HALF) = f_to_h8(xb[mm][bj][0] + gv[bj][0] * acc[ai][bj][m][0], xb[mm][bj][1] + gv[bj][1] * acc[ai][bj][m][1]); }
                __builtin_amdgcn_sched_barrier(0);
            }
        } else {
#pragma unroll
            for (int ai = 0; ai < 2; ++ai) {
                h16x8 xv[4][2];
#pragma unroll
                for (int m = 0; m < 4; ++m)
#pragma unroll
                    for (int bj = 0; bj < 2; ++bj) xv[m][bj] = *(const h16x8*)(xp + (size_t)(ai * HALF + m * 16) * D + bj * HALF);
#pragma unroll
                for (int m = 0; m < 4; ++m)
#pragma unroll
                    for (int bj = 0; bj < 2; ++bj) { f32x4 b0, b1; h8_to_f(xv[m][bj], b0, b1);
                        *(h16x8*)(xp + (size_t)(ai * HALF + m * 16) * D + bj * HALF) = f_to_h8(b0 + gv[bj][0] * acc[ai][bj][m][0], b1 + gv[bj][1] * acc[ai][bj][m][1]); }
            }
        }
    }
};
struct EpiWin {
    static constexpr bool PERM = true, CHAIN = false;
    bf16 *UA, *UB, *UC, *UG; const float* qkg;
    __device__ __forceinline__ void operator()(f32x4 (&acc)[2][2][4][2], const Unit& u, int wr, int wc, int fr, int fq) const {
        const int row0 = u.pm * BM + wr * 64 + fr;
        if (u.pn < 8) {
            const float* gp = qkg + (u.pn < 4 ? 0 : 64) + 8 * fq; const float qs = u.pn < 4 ? 0.125f * LOG2E : 1.0f;
            f32x4 gv[2][2];
#pragma unroll
            for (int bj = 0; bj < 2; ++bj)
#pragma unroll
                for (int n = 0; n < 2; ++n) gv[bj][n] = *(const f32x4*)(gp + 32 * bj + 4 * n) * qs;
#pragma unroll
            for (int ai = 0; ai < 2; ++ai)
#pragma unroll
                for (int m = 0; m < 4; ++m) {
                    float ss = 0.f;
#pragma unroll
                    for (int bj = 0; bj < 2; ++bj)
#pragma unroll
                        for (int n = 0; n < 2; ++n) { const f32x4 v = acc[ai][bj][m][n]; ss += (v[0] * v[0] + v[1] * v[1]) + (v[2] * v[2] + v[3] * v[3]); }
                    ss += __shfl_xor(ss, 16); ss += __shfl_xor(ss, 32);
                    const float rstd = 1.0f / sqrtf(ss * (1.0f / 64.0f) + EPS);
                    bf16* rowp = UA + (size_t)(row0 + ai * HALF + m * 16) * 3072 + u.pn * 256 + 64 * wc + 8 * fq;
#pragma unroll
                    for (int bj = 0; bj < 2; ++bj) { const f32x4 v0 = acc[ai][bj][m][0] * rstd * gv[bj][0], v1 = acc[ai][bj][m][1] * rstd * gv[bj][1];
                        u32x4 w; w.x = cvt_pk_bf16(v0[0], v0[1]); w.y = cvt_pk_bf16(v0[2], v0[3]); w.z = cvt_pk_bf16(v1[0], v1[1]); w.w = cvt_pk_bf16(v1[2], v1[3]);
                        *(u32x4*)(rowp + 32 * bj) = w; }
                }
            return;
        }
        bf16* dst; int ld, c0; bool sg = false;
        if (u.pn < 12) { dst = UA; ld = 3072; c0 = u.pn * 256; }
        else if (u.pn < 28) { dst = UB; ld = 4096; c0 = (u.pn - 12) * 256; }
        else if (u.pn < 42) { dst = UC; ld = 3584; c0 = (u.pn - 28) * 256; }
        else { dst = UG; ld = 6144; c0 = (u.pn - 42) * 256; sg = true; }
        const int col0 = c0 + wc * 32 + 8 * fq;
#pragma unroll
        for (int ai = 0; ai < 2; ++ai)
#pragma unroll
            for (int m = 0; m < 4; ++m) { bf16* rowp = dst + (size_t)(row0 + ai * HALF + m * 16) * ld + col0;
#pragma unroll
                for (int bj = 0; bj < 2; ++bj) { f32x4 v0 = acc[ai][bj][m][0], v1 = acc[ai][bj][m][1];
                    if (sg) {
                        u32x2 w8; w8.x = 0u; w8.y = 0u;
#pragma unroll
                        for (int e = 0; e < 4; ++e) { w8.x = __builtin_amdgcn_cvt_pk_u8_f32(sigmoidf_(v0[e]) * 254.0f + 1.0f, e, w8.x); w8.y = __builtin_amdgcn_cvt_pk_u8_f32(sigmoidf_(v1[e]) * 254.0f + 1.0f, e, w8.y); }
                        *(u32x2*)((unsigned char*)UG + (size_t)(row0 + ai * HALF + m * 16) * 6144 + col0 + bj * HALF) = w8;
                    } else {
                    u32x4 w; w.x = cvt_pk_bf16(v0[0], v0[1]); w.y = cvt_pk_bf16(v0[2], v0[3]); w.z = cvt_pk_bf16(v1[0], v1[1]); w.w = cvt_pk_bf16(v1[2], v1[3]);
                    *(u32x4*)(rowp + bj * HALF) = w; } } }
    }
};
struct EpiMerge {
    static constexpr bool PERM = true, CHAIN = true;
    const bf16* UG; bf16* Mb;
    __device__ __forceinline__ void operator()(f32x4 (&acc)[2][2][4][2], const Unit& u, int wr, int wc, int fr, int fq) const {
        const int row0 = u.pm * BM + wr * 64 + fr, col0 = u.pn * BM + wc * 32 + 8 * fq;
        const unsigned char* gb = (const unsigned char*)UG + (size_t)row0 * 6144 + (size_t)u.n * D + col0;
        const bool mid = u.n < 2; const int doff = mid ? D : 0;
#pragma unroll
        for (int ai = 0; ai < 2; ++ai) {
            u32x2 gw[4][2], g2[4][2];
#pragma unroll
            for (int m = 0; m < 4; ++m)
#pragma unroll
                for (int bj = 0; bj < 2; ++bj) { const unsigned char* p = gb + (size_t)(ai * HALF + m * 16) * 6144 + bj * HALF; gw[m][bj] = *(const u32x2*)p; g2[m][bj] = *(const u32x2*)(p + doff); }
#pragma unroll
            for (int m = 0; m < 4; ++m)
#pragma unroll
                for (int bj = 0; bj < 2; ++bj) { const u32x2 a = gw[m][bj], c = g2[m][bj];
                    float s[8];
#pragma unroll
                    for (int e = 0; e < 8; ++e) { const float den = (float)(((e < 4 ? c.x : c.y) >> (8 * (e & 3))) & 255u);
                        s[e] = (float)(((e < 4 ? a.x : a.y) >> (8 * (e & 3))) & 255u) * fast_rcp(mid ? den : 255.0f); }
                    f32x4& v0 = acc[ai][bj][m][0]; f32x4& v1 = acc[ai][bj][m][1];
                    v0 = v0 * (f32x4){s[0], s[1], s[2], s[3]}; v1 = v1 * (f32x4){s[4], s[5], s[6], s[7]}; }
        }
        if (u.n == 2) {
            bf16* mp = Mb + (size_t)row0 * D + col0;
#pragma unroll
            for (int ai = 0; ai < 2; ++ai)
#pragma unroll
                for (int m = 0; m < 4; ++m)
#pragma unroll
                    for (int bj = 0; bj < 2; ++bj) { const f32x4 v0 = acc[ai][bj][m][0], v1 = acc[ai][bj][m][1];
                        u32x4 w; w.x = cvt_pk_bf16(v0[0], v0[1]); w.y = cvt_pk_bf16(v0[2], v0[3]); w.z = cvt_pk_bf16(v1[0], v1[1]); w.w = cvt_pk_bf16(v1[2], v1[3]);
                        *(u32x4*)(mp + (size_t)(ai * HALF + m * 16) * D + bj * HALF) = w; }
        }
    }
};
}

#define XB_TMO      128
#define XB_XCNT(j)  (256  + 64 * (j))
#define XB_XSUB(j)  (1280 + 64 * (j))
#define XB_XGEN(j)  (2304 + 64 * (j))
#define XB_TOP      3328
#define XB_TOPGEN   3392
#define XCD_BAR_WORDS 3456
#define XB_SPIN_CAP (1u << 18)
__device__ __forceinline__ unsigned xb_ld(unsigned* p)              { return __hip_atomic_load(p, __ATOMIC_RELAXED, __HIP_MEMORY_SCOPE_AGENT); }
__device__ __forceinline__ unsigned xb_add(unsigned* p, unsigned v) { return __hip_atomic_fetch_add(p, v, __ATOMIC_RELAXED, __HIP_MEMORY_SCOPE_AGENT); }
__device__ __forceinline__ unsigned xb_xcc_id() { return (unsigned)__builtin_amdgcn_s_getreg((3 << 11) | 20) & 0xFu; }
#define XB_SPIN(cond, bar) do { unsigned _sp = 0; while (cond) { __builtin_amdgcn_s_sleep(1); \
    if ((++_sp & 255u) == 0u) { if (xb_ld(&(bar)[XB_TMO])) break; if (_sp > XB_SPIN_CAP) { atomicAdd(&(bar)[XB_TMO], 1u); break; } } } } while (0)
struct XcdBarrier { unsigned* bar; unsigned x; volatile LAS unsigned* st; };
__device__ __forceinline__ XcdBarrier xcd_barrier_post(unsigned* bar, volatile LAS unsigned* st) {
    XcdBarrier b; b.bar = bar; b.x = xb_xcc_id(); b.st = st;
    if (threadIdx.x == 0) (void)xb_add(&bar[XB_XCNT(b.x)], 1u);
    return b;
}
__device__ __forceinline__ void xcd_barrier_complete(unsigned* bar, unsigned x, unsigned& nloc, unsigned& nx) {
    const unsigned G = gridDim.x * gridDim.y * gridDim.z;
    unsigned sum, cnt, mine, sp = 0u;
    for (;;) {
        sum = 0u; cnt = 0u; mine = 0u;
#pragma unroll
        for (unsigned j = 0; j < 16; ++j) { const unsigned c = xb_ld(&bar[XB_XCNT(j)]); sum += c; cnt += (c > 0u) ? 1u : 0u; mine = (j == x) ? c : mine; }
        if (sum == G) break;
        __builtin_amdgcn_s_sleep(1);
        if ((++sp & 255u) == 0u) { if (xb_ld(&bar[XB_TMO])) break; if (sp > XB_SPIN_CAP) { atomicAdd(&bar[XB_TMO], 1u); break; } }
    }
    nloc = mine > 0u ? mine : 1u; nx = cnt > 0u ? cnt : 1u;
}
__device__ __forceinline__ void xcd_barrier(const XcdBarrier& b) {
    asm volatile("s_waitcnt vmcnt(0)" ::: "memory");
    __syncthreads();
    if (threadIdx.x == 0) {
        unsigned* bar = b.bar;
        __builtin_amdgcn_s_waitcnt(0);
        unsigned nloc = b.st[0], nx = b.st[1];
        if (nloc == 0u) { xcd_barrier_complete(bar, b.x, nloc, nx); b.st[0] = nloc; b.st[1] = nx; }
        const unsigned old = xb_add(&bar[XB_XSUB(b.x)], 1u);
        const unsigned gen = old / nloc;
        if (old + 1u == (gen + 1u) * nloc) {
            __builtin_amdgcn_fence(__ATOMIC_RELEASE, "agent");
            asm volatile("s_waitcnt vmcnt(0)" ::: "memory");
            const unsigned og = xb_add(&bar[XB_TOP], 1u);
            const unsigned tg = og / nx;
            if (og + 1u == (tg + 1u) * nx) xb_add(&bar[XB_TOPGEN], 1u);
            else XB_SPIN(xb_ld(&bar[XB_TOPGEN]) == tg, bar);
            __builtin_amdgcn_fence(__ATOMIC_ACQUIRE, "agent");
            xb_add(&bar[XB_XGEN(b.x)], 1u);
            asm volatile("s_waitcnt vmcnt(0)" ::: "memory");
        } else {
            XB_SPIN(xb_ld(&bar[XB_XGEN(b.x)]) == gen, bar);
            __builtin_amdgcn_fence(__ATOMIC_ACQUIRE, "agent");
            asm volatile("s_waitcnt vmcnt(0)" ::: "memory");
        }
    }
    __syncthreads();
}

__device__ __forceinline__ void transpose_item(const float* W, size_t ldw, bf16* WT, size_t K, LAS float* scr, int lane) {
#pragma unroll 8
    for (int i = 0; i < 32; ++i) { const int kk = 2 * i + (lane >> 5); scr[kk * 33 + (lane & 31)] = W[(size_t)kk * ldw + (lane & 31)]; }
    asm volatile("s_waitcnt lgkmcnt(0)" ::: "memory");
    const int c = lane & 7;
#pragma unroll
    for (int j = 0; j < 4; ++j) { const int n = (lane >> 3) + 8 * j; const LAS float* s = scr + (8 * c) * 33 + n;
        u32x4 o; o.x = cvt_pk_bf16(s[0 * 33], s[1 * 33]); o.y = cvt_pk_bf16(s[2 * 33], s[3 * 33]); o.z = cvt_pk_bf16(s[4 * 33], s[5 * 33]); o.w = cvt_pk_bf16(s[6 * 33], s[7 * 33]);
        *(u32x4*)(WT + (size_t)n * K + 8 * c) = o; }
    asm volatile("s_waitcnt lgkmcnt(0)" ::: "memory");
}

struct In {
    const float *x, *c, *w_ada, *b_ada, *norm_gains, *w_gate, *w_up, *w_down, *w_in, *qk_gains, *diff_lambda, *diff_out_gain, *rel_bias, *lb_logits, *hgrn_gain, *gla_w_up, *gla_b, *gla_gain, *w_branch, *w_out;
};

__device__ __forceinline__ void phase_prologue(const In& in, unsigned char* ws, LAS unsigned char* lds, int tid, int wave, int lane) {
    LAS float* condT = (LAS float*)lds;
    for (int i = tid; i < NBATCH * D; i += 512) { const int b = i >> 11, k = i & 2047; condT[k * 8 + b] = siluf_(in.c[i]); }
    __syncthreads();
    float* mod = (float*)(ws + WS_MOD);
    if (wave < 3) {
        const int id = (int)blockIdx.x + 256 * wave;
        if (id < 576) {
            const int l = id / 288, cg = id % 288, col = cg * 64 + lane;
            const float* W = in.w_ada + (size_t)l * D * NMOD + col;
            float acc[8];
#pragma unroll
            for (int b = 0; b < 8; ++b) acc[b] = 0.f;
            for (int k0 = 0; k0 < D; k0 += 16) {
                float w[16];
#pragma unroll
                for (int j = 0; j < 16; ++j) w[j] = W[(size_t)(k0 + j) * NMOD];
#pragma unroll
                for (int j = 0; j < 16; ++j) { const f32x4 c0 = *(const LAS f32x4*)(condT + (k0 + j) * 8), c1 = *(const LAS f32x4*)(condT + (k0 + j) * 8 + 4);
                    acc[0] += c0[0] * w[j]; acc[1] += c0[1] * w[j]; acc[2] += c0[2] * w[j]; acc[3] += c0[3] * w[j];
                    acc[4] += c1[0] * w[j]; acc[5] += c1[1] * w[j]; acc[6] += c1[2] * w[j]; acc[7] += c1[3] * w[j]; }
            }
            const float bb = in.b_ada[(size_t)l * NMOD + col];
#pragma unroll
            for (int b = 0; b < 8; ++b) mod[((size_t)l * 8 + b) * NMOD + col] = acc[b] + bb;
        }
    }
    LAS float* scr = (LAS float*)(lds + 65536 + wave * 8704);
    static_assert(65536 + 8 * 8704 <= RING_BYTES, "prologue LDS");
    const int gw = (int)blockIdx.x * 8 + wave, NGW = (int)gridDim.x * 8;
    constexpr int I_G = (D / 64) * (FF / 32);
    constexpr int I_IN = (D / 64) * 512;
    constexpr int I_B = (MIXW / 64) * (D / 32);
    constexpr int I_O = (D / 64) * (D / 32);
    constexpr int I_F = 256;
    constexpr int PER_L = 6 * I_G + I_IN + 3 * I_B + I_O + I_F;
    for (int it = gw; it < 2 * PER_L; it += NGW) {
        const int l = it / PER_L; int r = it % PER_L;
        if (r < 6 * I_G) {
            const int which = r / I_G, q = r % I_G, j = which & 1, kind = which >> 1;
            if (kind < 2) {
                const int nblk = FF / 32, kb = q / nblk, nb = q % nblk, n0 = nb * 32, k0 = kb * 64;
                const float* W = (kind == 0 ? in.w_gate : in.w_up) + ((size_t)(l * 2 + j) * D + k0) * FF + n0;
                bf16* WT = (bf16*)(ws + WS_WGU + (size_t)(l * 2 + j) * SZ_WGU) + (size_t)(256 * (n0 >> 7) + 128 * kind + (n0 & 127)) * D + k0;
                transpose_item(W, FF, WT, D, scr, lane);
            } else {
                const int nblk = D / 32, kb = q / nblk, nb = q % nblk, n0 = nb * 32, k0 = kb * 64;
                const float* W = in.w_down + ((size_t)(l * 2 + j) * FF + k0) * D + n0;
                bf16* WT = (bf16*)(ws + WS_WD + (size_t)(l * 2 + j) * SZ_WD) + (size_t)n0 * FF + k0;
                transpose_item(W, D, WT, FF, scr, lane);
            }
            continue;
        }
        r -= 6 * I_G;
        if (r < I_IN) {
            const int kb = r / 512, nb = r % 512, k0 = kb * 64;
            const int srcc = nb < 320 ? nb * 32 : 10256 + (nb - 320) * 32;
            int dstr = nb < 320 ? nb * 32 : 10752 + (nb - 320) * 32;
            if (nb < 64) { const int r0 = (nb * 32) & 255; dstr = (nb * 32 & ~255) + 128 * ((r0 & 63) >> 5) + 32 * (r0 >> 6); }
            const float* W = in.w_in + ((size_t)l * D + k0) * NIN + srcc;
            bf16* WT = (bf16*)(ws + WS_WIN + (size_t)l * SZ_WIN) + (size_t)dstr * D + k0;
            transpose_item(W, NIN, WT, D, scr, lane);
            continue;
        }
        r -= I_IN;
        if (r < 3 * I_B) {
            const int n = r / I_B, q = r % I_B, nblk = D / 32, kb = q / nblk, nb = q % nblk, n0 = nb * 32, k0 = kb * 64;
            const float* W = in.w_branch + ((size_t)(l * 3 + n) * MIXW + k0) * D + n0;
            bf16* WT = (bf16*)(ws + WS_WB + (size_t)l * SZ_WB) + ((size_t)n * D + n0) * MIXW + k0;
            transpose_item(W, D, WT, MIXW, scr, lane);
            continue;
        }
        r -= 3 * I_B;
        if (r < I_O) {
            const int nblk = D / 32, kb = r / nblk, nb = r % nblk, n0 = nb * 32, k0 = kb * 64;
            const float* W = in.w_out + ((size_t)l * D + k0) * D + n0;
            bf16* WT = (bf16*)(ws + WS_WO + (size_t)l * SZ_WO) + (size_t)n0 * D + k0;
            transpose_item(W, D, WT, D, scr, lane);
            continue;
        }
        r -= I_O;
        {
            const int kb = r >> 3, jcb = r & 7, k = kb * 64 + lane;
            const float* wr_ = in.w_in + ((size_t)l * D + k) * NIN + 10240;
            float wv[16];
#pragma unroll
            for (int q = 0; q < 4; ++q) { const f32x4 t = *(const f32x4*)(wr_ + 4 * q); wv[4 * q] = t[0]; wv[4 * q + 1] = t[1]; wv[4 * q + 2] = t[2]; wv[4 * q + 3] = t[3]; }
            const float* up = in.gla_w_up + (size_t)l * 16 * 512 + jcb * 64;
            bf16* WT = (bf16*)(ws + WS_WIN + (size_t)l * SZ_WIN) + (size_t)(10240 + jcb * 64) * D + k;
            for (int jc = 0; jc < 64; ++jc) {
                float a = 0.f;
#pragma unroll
                for (int q = 0; q < 16; ++q) a += wv[q] * up[q * 512 + jc];
                WT[(size_t)jc * D] = (bf16)(cvt_pk_bf16(a, 0.f) & 0xffffu);
            }
        }
    }
}

template <int MODE, bool SRC32>
__device__ __forceinline__ void phase_mod(const float* x32, _Float16* xh, float* out32, bf16* h, const float* gprev, const float* gain, const float* shiftv, const float* scalev, int wave, int lane) {
    const int blk = (int)blockIdx.x, b = blk >> 5, r0 = blk * 128 + wave * 16;
    f32x4 A[8], Sh[8], G3[8];
#pragma unroll
    for (int k = 0; k < 8; ++k) {
        const int d = 512 * (k >> 1) + 8 * lane + 4 * (k & 1);
        if (MODE != 2) { const f32x4 g = *(const f32x4*)(gain + d), sc = *(const f32x4*)(scalev + (size_t)b * NMOD + d); A[k] = g * (sc + 1.0f); Sh[k] = *(const f32x4*)(shiftv + (size_t)b * NMOD + d); }
        if (MODE != 0) G3[k] = *(const f32x4*)(gprev + d);
    }
    for (int i = 0; i < 16; ++i) {
        const size_t ro = (size_t)(r0 + i) * D + 8 * lane;
        f32x4 v[8]; float ss = 0.f;
#pragma unroll
        for (int j = 0; j < 4; ++j) {
            if (SRC32) { v[2 * j] = *(const f32x4*)(x32 + ro + 512 * j); v[2 * j + 1] = *(const f32x4*)(x32 + ro + 512 * j + 4); }
            else h8_to_f(*(const h16x8*)(xh + ro + 512 * j), v[2 * j], v[2 * j + 1]);
        }
#pragma unroll
        for (int k = 0; k < 8; ++k) ss += (v[k][0] * v[k][0] + v[k][1] * v[k][1]) + (v[k][2] * v[k][2] + v[k][3] * v[k][3]);
        ss = wave_sum(ss);
        float rstd = 1.0f / sqrtf(ss * (1.0f / D) + EPS);
        if (MODE != 0) {
            float s2 = 0.f;
#pragma unroll
            for (int k = 0; k < 8; ++k) { v[k] = v[k] * rstd * G3[k]; s2 += (v[k][0] * v[k][0] + v[k][1] * v[k][1]) + (v[k][2] * v[k][2] + v[k][3] * v[k][3]); }
#pragma unroll
            for (int j = 0; j < 4; ++j) {
                if (MODE == 1) *(h16x8*)(xh + ro + 512 * j) = f_to_h8(v[2 * j], v[2 * j + 1]);
                else { *(f32x4*)(out32 + ro + 512 * j) = v[2 * j]; *(f32x4*)(out32 + ro + 512 * j + 4) = v[2 * j + 1]; }
            }
            if (MODE == 2) continue;
            s2 = wave_sum(s2);
            rstd = 1.0f / sqrtf(s2 * (1.0f / D) + EPS);
        }
#pragma unroll
        for (int j = 0; j < 4; ++j) { const f32x4 o0 = v[2 * j] * rstd * A[2 * j] + Sh[2 * j], o1 = v[2 * j + 1] * rstd * A[2 * j + 1] + Sh[2 * j + 1];
            u32x4 w; w.x = cvt_pk_bf16(o0[0], o0[1]); w.y = cvt_pk_bf16(o0[2], o0[3]); w.z = cvt_pk_bf16(o1[0], o1[1]); w.w = cvt_pk_bf16(o1[2], o1[3]);
            *(u32x4*)(h + ro + 512 * j) = w; }
    }
}

__device__ __forceinline__ void st_wt32(void* p, unsigned v) { __hip_atomic_store((unsigned*)p, v, __ATOMIC_RELAXED, __HIP_MEMORY_SCOPE_AGENT); }
__device__ __forceinline__ void st_wt128(void* p, u32x4 v) { __hip_atomic_store((unsigned long long*)p, (unsigned long long)v.x | ((unsigned long long)v.y << 32), __ATOMIC_RELAXED, __HIP_MEMORY_SCOPE_AGENT);
    __hip_atomic_store((unsigned long long*)p + 1, (unsigned long long)v.z | ((unsigned long long)v.w << 32), __ATOMIC_RELAXED, __HIP_MEMORY_SCOPE_AGENT); }
__device__ __forceinline__ void item_publish(unsigned* cnt, int tid) {
    asm volatile("s_waitcnt vmcnt(0)" ::: "memory"); __syncthreads();
    if (tid == 0) __hip_atomic_fetch_add(cnt, 1u, __ATOMIC_RELAXED, __HIP_MEMORY_SCOPE_AGENT);
}
__device__ __forceinline__ void item_wait(unsigned* cnt, unsigned want, int tid) {
    if (tid == 0) { unsigned spins = 0;
        while (__hip_atomic_load(cnt, __ATOMIC_RELAXED, __HIP_MEMORY_SCOPE_AGENT) < want) { __builtin_amdgcn_s_sleep(4); if (++spins > (1u << 22)) break; }
        __builtin_amdgcn_fence(__ATOMIC_ACQUIRE, "agent"); asm volatile("s_waitcnt vmcnt(0)" ::: "memory"); }
    __syncthreads();
}

__device__ __forceinline__ void unpack16(const u32x4 a, const u32x4 b, float (&v)[16]) {
    v[0] = bflo(a.x); v[1] = bfhi(a.x); v[2] = bflo(a.y); v[3] = bfhi(a.y); v[4] = bflo(a.z); v[5] = bfhi(a.z); v[6] = bflo(a.w); v[7] = bfhi(a.w);
    v[8] = bflo(b.x); v[9] = bfhi(b.x); v[10] = bflo(b.y); v[11] = bfhi(b.y); v[12] = bflo(b.z); v[13] = bfhi(b.z); v[14] = bflo(b.w); v[15] = bfhi(b.w);
}
__device__ __forceinline__ void pack16(const float (&v)[16], u32x4& a, u32x4& b) {
    a.x = cvt_pk_bf16(v[0], v[1]); a.y = cvt_pk_bf16(v[2], v[3]); a.z = cvt_pk_bf16(v[4], v[5]); a.w = cvt_pk_bf16(v[6], v[7]);
    b.x = cvt_pk_bf16(v[8], v[9]); b.y = cvt_pk_bf16(v[10], v[11]); b.z = cvt_pk_bf16(v[12], v[13]); b.w = cvt_pk_bf16(v[14], v[15]);
}
struct ScanBufs { float *DB, *DC; };
__device__ __forceinline__ void phase_pre(bf16* UB, bf16* UC, const ScanBufs sb, int layer, const float* lb_logits, const float* gla_b, int it0, int it_end, int it_step, int lane) {
    for (int it = it0; it < it_end; it += it_step) {
        const int ck = it / 12, sub = it - ck * 12; const size_t row0 = (size_t)ck * 16;
        {
            const int type = sub < 8 ? 0 : 1, hh = type == 0 ? sub : sub - 8, ch = hh * 128 + 2 * lane, nch = type == 0 ? 1024 : 512;
            bf16* U = type == 0 ? UB : UC; const int ld = type == 0 ? 4096 : 3584;
            bf16* qp = U + row0 * ld + ch; bf16* fp = U + row0 * ld + (type == 0 ? 1024 : 3072) + ch; bf16* kp = U + row0 * ld + (type == 0 ? 1024 : 512) + ch;
            float par[2];
#pragma unroll
            for (int e = 0; e < 2; ++e) par[e] = type == 0 ? (layer == 0 ? 0.f : 1.0f / (1.0f + __expf(lb_logits[ch + e] - lb_logits[1024 + ch + e]))) : gla_b[ch + e];
            unsigned qw[16], fw[16], kw[16];
#pragma unroll
            for (int i = 0; i < 16; ++i) { qw[i] = *(const unsigned*)(qp + (size_t)i * ld); fw[i] = *(const unsigned*)(fp + (size_t)i * ld); kw[i] = type != 0 ? *(const unsigned*)(kp + (size_t)i * ld) : 0u; }
            float qo[2][16], po[2][16]; float Dv[2];
#pragma unroll
            for (int e = 0; e < 2; ++e) {
                float P = 1.0f;
#pragma unroll
                for (int i = 0; i < 16; ++i) {
                    const float qv = e ? bfhi(qw[i]) : bflo(qw[i]), zv = e ? bfhi(fw[i]) : bflo(fw[i]);
                    float ff, kf;
                    if (type == 0) {
                        const float en = fast_exp2(-fabsf(zv) * LOG2E);
                        const float sp = fast_rcp(1.0f + en), sn = en * sp;
                        const float s1 = zv >= 0.f ? sp : sn, s0 = zv >= 0.f ? sn : sp;
                        kf = (1.0f - par[e]) * s0; ff = par[e] + (1.0f - par[e]) * s1; qo[e][i] = qv;
                    } else {
                        const float xg = zv + par[e];
                        const float lsg = fminf(xg, 0.f) - __logf(1.0f + fast_exp2(-fabsf(xg) * LOG2E));
                        ff = fast_exp2(lsg * (LOG2E / 16.0f)); kf = e ? bfhi(kw[i]) : bflo(kw[i]); qo[e][i] = qv * 0.08838834764831845f;
                    }
                    P *= ff;
                    qo[e][i] *= P; po[e][i] = kf * fminf(fast_rcp(P), 5.5e34f);
                }
                Dv[e] = P;
            }
#pragma unroll
            for (int i = 0; i < 16; ++i) { st_wt32(qp + (size_t)i * ld, cvt_pk_bf16(qo[0][i], qo[1][i])); st_wt32(kp + (size_t)i * ld, cvt_pk_bf16(po[0][i], po[1][i])); }
            float* dp = (type == 0 ? sb.DB : sb.DC) + (size_t)ck * nch + ch;
            st_wt32(dp, __float_as_uint(Dv[0])); st_wt32(dp + 1, __float_as_uint(Dv[1]));
        }
    }
}

__device__ __forceinline__ void phase_post(const bf16* UB, const bf16* UC, bf16* Y, const float* hg  , const float* gg  , int r_0, int r_end, int r_step, int lane) {
    float g1[16], g2[16];
#pragma unroll
    for (int e = 0; e < 16; ++e) { g1[e] = hg[16 * (lane & 7) + e]; g2[e] = gg[16 * (lane & 15) + e]; }
    for (int r = r_0; r < r_end; r += r_step) {
        {
            const bf16* po = UB + (size_t)r * 4096 + 2048 + 16 * lane; const bf16* pg = UB + (size_t)r * 4096 + 3072 + 16 * lane;
            float v[16], g[16]; unpack16(*(const u32x4*)po, *(const u32x4*)(po + 8), v); unpack16(*(const u32x4*)pg, *(const u32x4*)(pg + 8), g);
            float ss = 0.f;
#pragma unroll
            for (int e = 0; e < 16; ++e) { v[e] = v[e] * sigmoidf_(g[e]); ss += v[e] * v[e]; }
            ss += __shfl_xor(ss, 1); ss += __shfl_xor(ss, 2); ss += __shfl_xor(ss, 4);
            const float rstd = 1.0f / sqrtf(ss * (1.0f / 128.0f) + EPS);
#pragma unroll
            for (int e = 0; e < 16; ++e) v[e] = v[e] * rstd * g1[e];
            u32x4 oa, ob; pack16(v, oa, ob);
            bf16* py = Y + (size_t)r * 3072 + 1024 + 16 * lane; *(u32x4*)py = oa; *(u32x4*)(py + 8) = ob;
        }
        {
            const bf16* po = UC + (size_t)r * 3584 + 1024 + 16 * lane; const bf16* pg = UC + (size_t)r * 3584 + 2048 + 16 * lane;
            float v[16], g[16]; unpack16(*(const u32x4*)po, *(const u32x4*)(po + 8), v); unpack16(*(const u32x4*)pg, *(const u32x4*)(pg + 8), g);
            float ss = 0.f;
#pragma unroll
            for (int e = 0; e < 16; ++e) ss += v[e] * v[e];
            ss += __shfl_xor(ss, 1); ss += __shfl_xor(ss, 2); ss += __shfl_xor(ss, 4); ss += __shfl_xor(ss, 8);
            const float rstd = 1.0f / sqrtf(ss * (1.0f / 256.0f) + EPS);
#pragma unroll
            for (int e = 0; e < 16; ++e) v[e] = v[e] * rstd * g2[e] * siluf_(g[e]);
            u32x4 oa, ob; pack16(v, oa, ob);
            bf16* py = Y + (size_t)r * 3072 + 2048 + 16 * lane; *(u32x4*)py = oa; *(u32x4*)(py + 8) = ob;
        }
    }
}

constexpr int AT_KROW = 288, AT_VROW = 288, AT_KBUF = 64 * AT_KROW, AT_VBUF = 64 * AT_VROW;
constexpr int AT_K = 0, AT_V = 2 * AT_KBUF, AT_TBL = AT_V + 2 * AT_VBUF, AT_END = AT_TBL + 1024;
static_assert(AT_END <= RING_BYTES && 4 * 16384 <= AT_TBL, "attention LDS");
__device__ __forceinline__ void attn_unit(LAS unsigned char* lds, const bf16* UA, bf16* Y, int bl, int h, int qb,
                                          const float* qkg, const float* rel_bias, const float* lamv, const float* dgain, float lam_init, int tid, int wave, int lane) {
    const int x = lane & 15, g = lane >> 4, m = wave >> 2, wq = wave & 3;
    float gqm = fabsf(qkg[lane]), gkm = fabsf(qkg[64 + lane]), bm = lane < 32 ? fabsf(rel_bias[lane * 8 + h]) : 0.f;
    gqm = wave_max(gqm); gkm = wave_max(gkm); bm = wave_max(bm);
    const float Mb = (8.0f * gqm * gkm * 1.02f + bm) * LOG2E + 1.0f;
    const float s01 = wave_sum(lamv[lane] * lamv[64 + lane]), s23 = wave_sum(lamv[128 + lane] * lamv[192 + lane]);
    const float lam = __expf(s01) - __expf(s23) + lam_init;
    const float cb_far = rel_bias[15 * 8 + h] * LOG2E - Mb;
    LAS float* tbl = (LAS float*)(lds + AT_TBL);
    if (tid < 255) { const int rel = tid - 191, n = rel < 0 ? -rel : rel;
        int bk = n < 8 ? n : (8 + (31 - __clz(n * n)) - 6); if (bk > 15) bk = 15; if (rel > 0) bk += 16;
        tbl[tid] = rel_bias[bk * 8 + h] * LOG2E; }
    const int q0 = qb * 128 + wq * 32, qc = qb * 2 + (wq >> 1);
    bf16x8 qr[2][2];
#pragma unroll
    for (int qb2 = 0; qb2 < 2; ++qb2)
#pragma unroll
        for (int ks = 0; ks < 2; ++ks) qr[qb2][ks] = *(const bf16x8*)(UA + (size_t)(bl * SEQ + q0 + 16 * qb2 + x) * 3072 + h * 128 + m * 64 + 32 * ks + 8 * g);
    f32x4 O[8][2];
#pragma unroll
    for (int db = 0; db < 8; ++db)
#pragma unroll
        for (int qb2 = 0; qb2 < 2; ++qb2) O[db][qb2] = (f32x4){0.f, 0.f, 0.f, 0.f};
    float lsum[2] = {0.f, 0.f};
    const int NT = 2 * qb + 2;
    const bf16* ksrc = UA + (size_t)(bl * SEQ) * 3072 + 1024 + h * 128;
    const bf16* vsrc = UA + (size_t)(bl * SEQ) * 3072 + 2048 + h * 128;
    u32x4 rk[2], rv[2];
#define AT_LOAD(kt) do { _Pragma("unroll") for (int j = 0; j < 2; ++j) { const int c = tid + 512 * j; \
        rk[j] = *(const u32x4*)(ksrc + (size_t)((kt) * 64 + (c >> 4)) * 3072 + (c & 15) * 8); \
        rv[j] = *(const u32x4*)(vsrc + (size_t)((kt) * 64 + (c >> 4)) * 3072 + (c & 15) * 8); } } while (0)
#define AT_STORE(buf) do { _Pragma("unroll") for (int j = 0; j < 2; ++j) { const int c = tid + 512 * j; \
        *(LAS u32x4*)(lds + AT_K + (buf) * AT_KBUF + (c >> 4) * AT_KROW + (c & 15) * 16) = rk[j]; \
        *(LAS u32x4*)(lds + AT_V + (buf) * AT_VBUF + (c >> 4) * AT_VROW + (c & 15) * 16) = rv[j]; } } while (0)
    AT_LOAD(0); AT_STORE(0);
    __syncthreads();
    const int koff = x * AT_KROW + m * 128 + g * 16;
    const int voff = (4 * g + (x >> 2)) * AT_VROW + (4 * (x & 3)) * 2;
    for (int kt = 0; kt < NT; ++kt) {
        const int buf = kt & 1;
        if (kt + 1 < NT) AT_LOAD(kt + 1);
        if (kt <= qc) {
            const bool far_ = (qc - kt) >= 3;
            const LAS unsigned char* Kb = lds + AT_K + buf * AT_KBUF;
            const LAS unsigned char* Vb = lds + AT_V + buf * AT_VBUF;
            const float cinit = far_ ? cb_far : -Mb;
            f32x4 S[4][2];
            bf16x8 kf[4][2];
#pragma unroll
            for (int kb = 0; kb < 4; ++kb)
#pragma unroll
                for (int ks = 0; ks < 2; ++ks) kf[kb][ks] = *(const LAS bf16x8*)(Kb + koff + (16 * kb) * AT_KROW + ks * 64);
#pragma unroll
            for (int kb = 0; kb < 4; ++kb)
#pragma unroll
                for (int qb2 = 0; qb2 < 2; ++qb2) S[kb][qb2] = (f32x4){cinit, cinit, cinit, cinit};
            __builtin_amdgcn_s_setprio(1);
#pragma unroll
            for (int ks = 0; ks < 2; ++ks)
#pragma unroll
                for (int kb = 0; kb < 4; ++kb)
#pragma unroll
                    for (int qb2 = 0; qb2 < 2; ++qb2) S[kb][qb2] = __builtin_amdgcn_mfma_f32_16x16x32_bf16(kf[kb][ks], qr[qb2][ks], S[kb][qb2], 0, 0, 0);
            __builtin_amdgcn_s_setprio(0);
            if (!far_) {
                const int rbase = 64 * kt - (q0 + x) + 191 + 4 * g;
#pragma unroll
                for (int kb = 0; kb < 4; ++kb)
#pragma unroll
                    for (int qb2 = 0; qb2 < 2; ++qb2)
#pragma unroll
                        for (int i = 0; i < 4; ++i) S[kb][qb2][i] += tbl[rbase + 16 * kb - 16 * qb2 + i];
            }
            u32x4 P[2][2];
#pragma unroll
            for (int kb = 0; kb < 4; ++kb)
#pragma unroll
                for (int qb2 = 0; qb2 < 2; ++qb2) {
#pragma unroll
                    for (int i = 0; i < 4; ++i) { S[kb][qb2][i] = fast_exp2(S[kb][qb2][i]); lsum[qb2] += S[kb][qb2][i]; }
                    const unsigned w0 = cvt_pk_bf16(S[kb][qb2][0], S[kb][qb2][1]), w1 = cvt_pk_bf16(S[kb][qb2][2], S[kb][qb2][3]);
                    if (kb & 1) { P[kb >> 1][qb2].z = w0; P[kb >> 1][qb2].w = w1; } else { P[kb >> 1][qb2].x = w0; P[kb >> 1][qb2].y = w1; }
                }
#pragma unroll
            for (int s2 = 0; s2 < 2; ++s2) {
#pragma unroll
                for (int dq = 0; dq < 2; ++dq) {
                    bf16x8 vf[4];
#pragma unroll
                    for (int e = 0; e < 4; ++e) { const LAS unsigned char* vp = Vb + voff + (32 * s2) * AT_VROW + (16 * (4 * dq + e)) * 2;
                        const s16x4 lo = __builtin_bit_cast(s16x4, __builtin_amdgcn_ds_read_tr16_b64_v4i16((LAS v4i16_t*)vp)), hi4 = __builtin_bit_cast(s16x4, __builtin_amdgcn_ds_read_tr16_b64_v4i16((LAS v4i16_t*)(vp + 16 * AT_VROW)));
                        vf[e] = (bf16x8){lo[0], lo[1], lo[2], lo[3], hi4[0], hi4[1], hi4[2], hi4[3]}; }
                    __builtin_amdgcn_s_setprio(1);
#pragma unroll
                    for (int e = 0; e < 4; ++e)
#pragma unroll
                        for (int qb2 = 0; qb2 < 2; ++qb2) O[4 * dq + e][qb2] = __builtin_amdgcn_mfma_f32_16x16x32_bf16(vf[e], __builtin_bit_cast(bf16x8, P[s2][qb2]), O[4 * dq + e][qb2], 0, 0, 0);
                    __builtin_amdgcn_s_setprio(0);
                    __builtin_amdgcn_sched_barrier(0);
                }
            }
        }
        if (kt + 1 < NT) AT_STORE(buf ^ 1);
        __syncthreads();
    }
#undef AT_LOAD
#undef AT_STORE
    float sc[2];
#pragma unroll
    for (int qb2 = 0; qb2 < 2; ++qb2) { float l = lsum[qb2]; l += __shfl_xor(l, 16); l += __shfl_xor(l, 32); sc[qb2] = (m == 0 ? 1.0f : lam) / l; }
#pragma unroll
    for (int db = 0; db < 8; ++db)
#pragma unroll
        for (int qb2 = 0; qb2 < 2; ++qb2) O[db][qb2] = O[db][qb2] * sc[qb2];
    LAS float* X = (LAS float*)(lds + wq * 16384);
    if (m == 1) {
#pragma unroll
        for (int db = 0; db < 8; ++db)
#pragma unroll
            for (int qb2 = 0; qb2 < 2; ++qb2) *(LAS f32x4*)(X + ((db * 2 + qb2) * 64 + lane) * 4) = O[db][qb2];
    }
    __syncthreads();
    if (m == 0) {
#pragma unroll
        for (int qb2 = 0; qb2 < 2; ++qb2) {
            float ss = 0.f;
#pragma unroll
            for (int db = 0; db < 8; ++db) { O[db][qb2] = O[db][qb2] - *(const LAS f32x4*)(X + ((db * 2 + qb2) * 64 + lane) * 4);
                ss += (O[db][qb2][0] * O[db][qb2][0] + O[db][qb2][1] * O[db][qb2][1]) + (O[db][qb2][2] * O[db][qb2][2] + O[db][qb2][3] * O[db][qb2][3]); }
            ss += __shfl_xor(ss, 16); ss += __shfl_xor(ss, 32);
            const float rstd = (1.0f / sqrtf(ss * (1.0f / 128.0f) + EPS)) * (1.0f - lam_init);
            bf16* yp = Y + (size_t)(bl * SEQ + q0 + 16 * qb2 + x) * 3072 + h * 128 + 4 * g;
#pragma unroll
            for (int db = 0; db < 8; ++db) { const f32x4 dgv = *(const f32x4*)(dgain + 16 * db + 4 * g); const f32x4 o = O[db][qb2] * dgv * rstd;
                *(u32x2*)(yp + 16 * db) = (u32x2){cvt_pk_bf16(o[0], o[1]), cvt_pk_bf16(o[2], o[3])}; }
        }
    }
    __syncthreads();
}

constexpr int S2_ROW = 272;
constexpr int S2_VROW = 288;
constexpr int S2_Q = 0, S2_KP = 64 * S2_ROW, S2_VT = 2 * 64 * S2_ROW, S2_D = S2_VT + 64 * S2_VROW, S2_O = S2_D + 2048, S2_END = S2_O + 64 * S2_ROW;
static_assert(S2_END <= RING_BYTES, "scan LDS");
__device__ __forceinline__ void scan_unit(LAS unsigned char* lds, bf16* UB, bf16* UC, const ScanBufs sb, unsigned* pre_cnt, unsigned pre_want, unsigned* scan_cnt, int type, int bl, int h, int j, int tid, int wave, int lane) {
    item_wait(pre_cnt, pre_want, tid);
    const bf16 *qsrc, *psrc; const float* dsrc; bf16* vdst; int ld, nch;
    if (type == 0) { ld = 4096; nch = 1024; qsrc = UB + h * 128; psrc = UB + 1024 + h * 128; dsrc = sb.DB + h * 128; vdst = UB + 2048 + h * 128; }
    else           { ld = 3584; nch = 512;  qsrc = UC + h * 128; psrc = UC + 512 + h * 128;  dsrc = sb.DC + h * 128; vdst = UC + 1024 + h * 256 + 128 * j; }
    const size_t rowb = (size_t)bl * SEQ;
    u32x4 rq[2], rp[2], rvt[2]; float rd;
#define S2_LOAD(tb) do { const size_t r0_ = rowb + (size_t)(tb) * 64, ck0_ = r0_ >> 4; \
        _Pragma("unroll") for (int k = 0; k < 2; ++k) { const int chn = tid + 512 * k; \
            rq[k] = *(const u32x4*)(qsrc + (r0_ + (chn >> 4)) * ld + (chn & 15) * 8); rp[k] = *(const u32x4*)(psrc + (r0_ + (chn >> 4)) * ld + (chn & 15) * 8); \
            rvt[k] = *(const u32x4*)(vdst + (r0_ + (chn >> 4)) * ld + (chn & 15) * 8); } \
        rd = dsrc[(ck0_ + (tid >> 7)) * nch + (tid & 127)]; } while (0)
    f32x4 S[8];
#pragma unroll
    for (int e = 0; e < 8; ++e) S[e] = (f32x4){0.f, 0.f, 0.f, 0.f};
    const int x = lane & 15, g = lane >> 4;
    S2_LOAD(0);
    for (int tb = 0; tb < SEQ / 64; ++tb) {
#pragma unroll
        for (int k = 0; k < 2; ++k) { const int chn = tid + 512 * k;
            *(LAS u32x4*)(lds + S2_Q + (chn >> 4) * S2_ROW + (chn & 15) * 16) = rq[k]; *(LAS u32x4*)(lds + S2_KP + (chn >> 4) * S2_ROW + (chn & 15) * 16) = rp[k];
            *(LAS u32x4*)(lds + S2_VT + (chn >> 4) * S2_VROW + (chn & 15) * 16) = rvt[k]; }
        *(LAS float*)(lds + S2_D + tid * 4) = rd;
        __syncthreads();
        if (tb + 1 < SEQ / 64) S2_LOAD(tb + 1);
        s16x4 sa[4], vf[4];
#pragma unroll
        for (int cc = 0; cc < 4; ++cc) {
            const LAS unsigned char* qrow = lds + S2_Q + (16 * cc + x) * S2_ROW;
            const LAS unsigned char* prow = lds + S2_KP + (16 * cc + x) * S2_ROW;
            f32x4 st = (f32x4){0.f, 0.f, 0.f, 0.f};
#pragma unroll
            for (int i = 0; i < 4; ++i) st = __builtin_amdgcn_mfma_f32_16x16x32_bf16(*(const LAS bf16x8*)(prow + 64 * i + 16 * g), *(const LAS bf16x8*)(qrow + 64 * i + 16 * g), st, 0, 0, 0);
#pragma unroll
            for (int r = 0; r < 4; ++r) if (4 * g + r > x) st[r] = 0.f;
            const u32x2 sw = (u32x2){cvt_pk_bf16(st[0], st[1]), cvt_pk_bf16(st[2], st[3])};
            sa[cc] = __builtin_bit_cast(s16x4, sw);
            vf[cc] = __builtin_bit_cast(s16x4, __builtin_amdgcn_ds_read_tr16_b64_v4i16((LAS v4i16_t*)(lds + S2_VT + (16 * cc + 4 * g + (x >> 2)) * S2_VROW + (16 * wave + 4 * (x & 3)) * 2)));
        }
        u32x2 qa[2][8];
#define S2_FETCH(cc, bufi) do { const LAS unsigned char* qrow_ = lds + S2_Q + (16 * (cc) + x) * S2_ROW; \
            _Pragma("unroll") for (int i = 0; i < 4; ++i) { qa[bufi][2 * i] = *(const LAS u32x2*)(qrow_ + 64 * i + 8 * g); qa[bufi][2 * i + 1] = *(const LAS u32x2*)(qrow_ + 64 * i + 32 + 8 * g); } } while (0)
        S2_FETCH(0, 0);
#pragma unroll
        for (int cc = 0; cc < 4; ++cc) {
            const int bi = cc & 1;
            f32x4 dv[8]; s16x4 ka[8];
#pragma unroll
            for (int rb = 0; rb < 8; ++rb) { dv[rb] = *(const LAS f32x4*)(lds + S2_D + (cc * 128 + 16 * rb + 4 * g) * 4); ka[rb] = __builtin_bit_cast(s16x4, __builtin_amdgcn_ds_read_tr16_b64_v4i16((LAS v4i16_t*)(lds + S2_KP + (16 * cc + 4 * g + (x >> 2)) * S2_ROW + (16 * rb + 4 * (x & 3)) * 2))); }
            if (cc < 3) { if (bi == 0) S2_FETCH(cc + 1, 1); else S2_FETCH(cc + 1, 0); }
            f32x4 o0 = (f32x4){0.f, 0.f, 0.f, 0.f}, o1 = (f32x4){0.f, 0.f, 0.f, 0.f};
#pragma unroll
            for (int i = 0; i < 4; ++i) {
                const u32x4 sfw = (u32x4){cvt_pk_bf16(S[2 * i][0], S[2 * i][1]), cvt_pk_bf16(S[2 * i][2], S[2 * i][3]), cvt_pk_bf16(S[2 * i + 1][0], S[2 * i + 1][1]), cvt_pk_bf16(S[2 * i + 1][2], S[2 * i + 1][3])};
                const u32x4 qaw = (u32x4){qa[bi][2 * i].x, qa[bi][2 * i].y, qa[bi][2 * i + 1].x, qa[bi][2 * i + 1].y};
                if (i & 1) o1 = __builtin_amdgcn_mfma_f32_16x16x32_bf16(__builtin_bit_cast(bf16x8, qaw), __builtin_bit_cast(bf16x8, sfw), o1, 0, 0, 0);
                else       o0 = __builtin_amdgcn_mfma_f32_16x16x32_bf16(__builtin_bit_cast(bf16x8, qaw), __builtin_bit_cast(bf16x8, sfw), o0, 0, 0, 0);
            }
#pragma unroll
            for (int rb = 0; rb < 8; ++rb) S[rb] = __builtin_amdgcn_mfma_f32_16x16x16bf16_1k(ka[rb], vf[cc], S[rb], 0, 0, 0) * dv[rb];
            o0 = __builtin_amdgcn_mfma_f32_16x16x16bf16_1k(sa[cc], vf[cc], o0, 0, 0, 0);
            o0 = o0 + o1;
#pragma unroll
            for (int r = 0; r < 4; ++r) *(LAS unsigned short*)(lds + S2_O + (16 * cc + 4 * g + r) * S2_ROW + (16 * wave + x) * 2) = (unsigned short)(cvt_pk_bf16(o0[r], 0.f) & 0xffffu);
        }
#undef S2_FETCH
        __syncthreads();
#pragma unroll
        for (int k = 0; k < 2; ++k) { const int ch = tid + 512 * k, row = ch >> 4, c16 = ch & 15;
            st_wt128(vdst + (rowb + (size_t)tb * 64 + row) * ld + c16 * 8, *(const LAS u32x4*)(lds + S2_O + row * S2_ROW + c16 * 16)); }
    }
#undef S2_LOAD
    item_publish(scan_cnt, tid);
}

#ifndef PROBE
#define PROBE 0
#endif
#ifndef MK_PER_PHASE
#define MK_PER_PHASE 0
#endif
constexpr int NPH_LAYER = 14, NPH = 1 + 2 * NPH_LAYER + 1;
struct Args { const float* in[20]; float* out; unsigned char* ws; int ph_lo, ph_hi, li, pad; };

__global__ void __launch_bounds__(512, 2) fwd(Args a) {
    extern __shared__ __attribute__((aligned(16))) unsigned char lds_[];
    LAS unsigned char* lds = (LAS unsigned char*)lds_;
    const int tid = threadIdx.x, lane = tid & 63, wave = __builtin_amdgcn_readfirstlane(tid >> 6);
    const int G = (int)gridDim.x, blk = (int)blockIdx.x;
    for (int u = tid; u < (LDS_BYTES - LDSCTL_OFF) / 4; u += 512) ((LAS unsigned*)(lds + LDSCTL_OFF))[u] = 0u;
    __syncthreads();
    volatile LAS unsigned* MISC = (volatile LAS unsigned*)(lds + MISC_OFF);
    unsigned char* ws = a.ws;
    unsigned* ctl = (unsigned*)(ws + WS_CTL);
    const int lo = a.ph_lo, hi = a.ph_hi;
    XcdBarrier bar; bar.bar = ctl + CW_BAR; bar.x = 0; bar.st = nullptr;
    if (hi - lo > 1) bar = xcd_barrier_post(ctl + CW_BAR + a.li * XCD_BAR_WORDS, MISC + 8);
    In in;
    in.x = a.in[0]; in.c = a.in[1]; in.w_ada = a.in[2]; in.b_ada = a.in[3]; in.norm_gains = a.in[4]; in.w_gate = a.in[5]; in.w_up = a.in[6]; in.w_down = a.in[7]; in.w_in = a.in[8];
    in.qk_gains = a.in[9]; in.diff_lambda = a.in[10]; in.diff_out_gain = a.in[11]; in.rel_bias = a.in[12]; in.lb_logits = a.in[13]; in.hgrn_gain = a.in[14]; in.gla_w_up = a.in[15];
    in.gla_b = a.in[16]; in.gla_gain = a.in[17]; in.w_branch = a.in[18]; in.w_out = a.in[19];
    float* out = a.out;
    float* mod = (float*)(ws + WS_MOD);
    bf16* H = (bf16*)(ws + WS_H); bf16* ACT = (bf16*)(ws + WS_ACT);
    bf16* UA = (bf16*)(ws + WS_UA); bf16* UB = (bf16*)(ws + WS_UB); bf16* UC = (bf16*)(ws + WS_UC); bf16* UG = (bf16*)(ws + WS_UG); bf16* Y = (bf16*)(ws + WS_Y); _Float16* XH = (_Float16*)(ws + WS_XH);
    const ScanBufs sb{(float*)(ws + WS_DB), (float*)(ws + WS_DC)};
    int ph = 0;
#define IN_(k) (lo <= (k) && (k) < hi)
#define SEAM() do { if (IN_(ph) && IN_(ph + 1)) xcd_barrier(bar); ++ph; asm volatile("" : "+v"(tid_)); lane_ = tid_ & 63; wave_ = __builtin_amdgcn_readfirstlane(tid_ >> 6); } while (0)
    int tid_ = tid, lane_ = lane, wave_ = wave;
#define PBAR() do { if (hi - lo > 1) xcd_barrier(bar); asm volatile("" : "+v"(tid_)); lane_ = tid_ & 63; wave_ = __builtin_amdgcn_readfirstlane(tid_ >> 6); } while (0)

    for (int rep = 0; rep < (PROBE == 7 ? 2 : 1); ++rep) { if (rep) PBAR();
    if (IN_(ph)) phase_prologue(in, ws, lds, tid_, wave_, lane_); }
    SEAM();
    for (int l = 0; l < 2; ++l) {
        const float* modl = mod + (size_t)l * 8 * NMOD;
        const float* gains = in.norm_gains + (size_t)l * 4 * D;
        const float lam_init = l == 0 ? 0.2f : 0.35550906759f;
        if (IN_(ph)) {
            if (l == 0) phase_mod<0, true>(in.x, nullptr, nullptr, H, nullptr, gains, modl, modl + D, wave_, lane_);
            else phase_mod<1, false>(nullptr, XH, nullptr, H, in.norm_gains + (size_t)(l - 1) * 4 * D + 3 * D, gains, modl, modl + D, wave_, lane_);
        }
        SEAM();
        for (int rep = 0; rep < (PROBE == 1 ? 2 : 1); ++rep) { if (rep) PBAR();
        if (IN_(ph)) { pg8::Gemm g{H, (const bf16*)(ws + WS_WGU + (size_t)(l * 2 + 0) * SZ_WGU), D, D, D, 0, 0}; pg8::StaticOrder S; S.init(M, 2 * FF, G, blk, 1);
            pg8::EpiSwiglu E{ACT}; pg8::gemm_phase(lds, g, S, E, tid_); } }
        SEAM();
        if (IN_(ph)) { pg8::Gemm g{ACT, (const bf16*)(ws + WS_WD + (size_t)(l * 2 + 0) * SZ_WD), FF, FF, FF, 0, 0}; pg8::StaticOrder S; S.init(M, D, G, blk, 1);
            pg8::EpiResid E{l == 0 ? in.x : nullptr, XH, modl + 2 * D, 0.5f, 0}; pg8::gemm_phase(lds, g, S, E, tid_); }
        SEAM();
        for (int rep = 0; rep < (PROBE == 4 ? 2 : 1); ++rep)
        if (IN_(ph)) phase_mod<0, false>(nullptr, XH, nullptr, H, nullptr, gains + D, modl + 3 * D, modl + 4 * D, wave_, lane_);
        SEAM();
        for (int half = 0; half < 2; ++half) {
            bf16* Hh = H + (size_t)half * MH * D;
            if (IN_(ph)) { pg8::Gemm g{Hh, (const bf16*)(ws + WS_WIN + (size_t)l * SZ_WIN), D, D, D, 0, 0}; pg8::StaticOrder S; S.init(MH, NWIN, G, blk, 1);
                pg8::EpiWin E{UA, UB, UC, UG, in.qk_gains + l * 128}; pg8::gemm_phase(lds, g, S, E, tid_);
                if (PROBE == 2) { PBAR(); pg8::gemm_phase(lds, g, S, E, tid_); } }
            SEAM();
            if (IN_(ph)) {
                constexpr int Q_PRE = 768, Q_SCAN = Q_PRE + 64, Q_ATT = Q_SCAN + 1024, Q_POST = Q_ATT + 256;
                unsigned* qh = ctl + CW_QUEUE + 64 * (l * 2 + half);
                unsigned* pre_cnt = ctl + CW_QUEUE + 64 * (8 + l * 2 + half); unsigned* scan_cnt = ctl + CW_QUEUE + 64 * (16 + l * 2 + half);
                for (;;) {
                    if (tid_ == 0) MISC[16] = __hip_atomic_fetch_add(qh, 1u, __ATOMIC_RELAXED, __HIP_MEMORY_SCOPE_AGENT);
                    __syncthreads();
                    const int item = (int)MISC[16];
                    __syncthreads();
                    if (item >= Q_POST) break;
                    int t2 = tid_; asm volatile("" : "+v"(t2)); const int l2 = t2 & 63, w2 = __builtin_amdgcn_readfirstlane(t2 >> 6);
                    if (item < Q_PRE) { phase_pre(UB, UC, sb, l, in.lb_logits, in.gla_b + l * 512, item * 16 + w2, item * 16 + 16, 8, l2); item_publish(pre_cnt, t2); }
                    else if (item < Q_PRE + 32) { const int id = item - Q_PRE; scan_unit(lds, UB, UC, sb, pre_cnt, Q_PRE, scan_cnt, 0, id >> 3, id & 7, 0, t2, w2, l2); }
                    else if (item < Q_SCAN) { const int id = item - Q_PRE - 32; scan_unit(lds, UB, UC, sb, pre_cnt, Q_PRE, scan_cnt, 1, id >> 3, (id >> 1) & 3, id & 1, t2, w2, l2); }
                    else if (item < Q_ATT) { const int id = item - Q_SCAN, qb = 31 - ((id & 255) >> 3), bh = (id >> 8) * 8 + (id & 7);
                        attn_unit(lds, UA, Y, bh >> 3, bh & 7, qb, in.qk_gains + l * 128, in.rel_bias, in.diff_lambda + l * 256, in.diff_out_gain + l * 128, lam_init, t2, w2, l2); }
                    else { const int id = item - Q_ATT; item_wait(scan_cnt, 64u, t2); phase_post(UB, UC, Y, in.hgrn_gain + l * 128, in.gla_gain + l * 256, id * 64 + w2, id * 64 + 64, 8, l2); }
                }
            }
            SEAM();
            if (IN_(ph)) { pg8::Gemm g{Y, (const bf16*)(ws + WS_WB + (size_t)l * SZ_WB), 3072, MIXW, MIXW, (size_t)MIXW, (size_t)D * MIXW}; pg8::StaticOrder S; S.init(MH, D, G, blk, 3);
                pg8::EpiMerge E{UG, Hh}; pg8::gemm_phase(lds, g, S, E, tid_);
                if (PROBE == 6) { PBAR(); pg8::gemm_phase(lds, g, S, E, tid_); } }
            SEAM();
        }
        if (IN_(ph)) { pg8::Gemm g{H, (const bf16*)(ws + WS_WO + (size_t)l * SZ_WO), D, D, D, 0, 0}; pg8::StaticOrder S; S.init(M, D, G, blk, 1);
            pg8::EpiResid E{nullptr, XH, modl + 5 * D, 1.0f, 0}; pg8::gemm_phase(lds, g, S, E, tid_); }
        SEAM();
        for (int rep = 0; rep < (PROBE == 4 ? 2 : 1); ++rep)
        if (IN_(ph)) phase_mod<0, false>(nullptr, XH, nullptr, H, nullptr, gains + 2 * D, modl + 6 * D, modl + 7 * D, wave_, lane_);
        SEAM();
        for (int rep = 0; rep < (PROBE == 1 ? 2 : 1); ++rep) { if (rep) PBAR();
        if (IN_(ph)) { pg8::Gemm g{H, (const bf16*)(ws + WS_WGU + (size_t)(l * 2 + 1) * SZ_WGU), D, D, D, 0, 0}; pg8::StaticOrder S; S.init(M, 2 * FF, G, blk, 1);
            pg8::EpiSwiglu E{ACT}; pg8::gemm_phase(lds, g, S, E, tid_); } }
        SEAM();
        if (IN_(ph)) { pg8::Gemm g{ACT, (const bf16*)(ws + WS_WD + (size_t)(l * 2 + 1) * SZ_WD), FF, FF, FF, 0, 0}; pg8::StaticOrder S; S.init(M, D, G, blk, 1);
            pg8::EpiResid E{nullptr, XH, modl + 8 * D, 0.5f, 0}; pg8::gemm_phase(lds, g, S, E, tid_); }
        SEAM();
    }
    if (IN_(ph)) phase_mod<2, false>(nullptr, XH, out, nullptr, in.norm_gains + (size_t)1 * 4 * D + 3 * D, nullptr, nullptr, nullptr, wave_, lane_);
#undef IN_
#undef SEAM
#undef PBAR
}

extern "C" void kernel_launch(void* const* d_in, const int* in_sizes, int n_in, void* d_out, int out_size, void* d_ws, size_t ws_size, hipStream_t stream) {
    static int ready = 0;
    if (ready == 0) {
        if (n_in != 20 || out_size != M * D || ws_size < WS_END) { fprintf(stderr, "kernel_launch: unexpected shapes (n_in %d, out %d, ws %zu < %zu)\n", n_in, out_size, ws_size, (size_t)WS_END); ready = -1; return; }
        if (hipFuncSetAttribute((const void*)fwd, hipFuncAttributeMaxDynamicSharedMemorySize, LDS_BYTES) != hipSuccess) { fprintf(stderr, "kernel_launch: hipFuncSetAttribute failed\n"); ready = -1; return; }
        (void)hipGetLastError();
        ready = 1;
    }
    if (ready < 0) return;
    if (hipMemsetAsync((char*)d_ws + WS_CTL, 0, CTL_ZERO_BYTES, stream) != hipSuccess) return;
    Args a{};
    for (int i = 0; i < 20; ++i) a.in[i] = (const float*)d_in[i];
    a.out = (float*)d_out; a.ws = (unsigned char*)d_ws; a.li = 0; a.pad = 0;
#if MK_PER_PHASE
    for (int p = 0; p < NPH; ++p) { a.ph_lo = p; a.ph_hi = p + 1; hipLaunchKernelGGL(fwd, dim3(256), dim3(512), LDS_BYTES, stream, a); }
#else
    a.ph_lo = 0; a.ph_hi = NPH;
    hipLaunchKernelGGL(fwd, dim3(256), dim3(512), LDS_BYTES, stream, a);
#endif
}
```
